# Optimizing an MI355X kernel written in HIP

```python
import jax, jax.numpy as jnp
from jax import lax
import numpy as np

D_MODEL = 1024
BATCH = 16
SEQ = 256
DEPTH = 1
DEC_BATCH = 8
DEC_SEQ = 1024
PAST_LEN = 256

GRID_W = 64
HEAD_DIM = 64
RET_HEADS = 8
RET_DK = 64
RET_DV = 64
RET_QK_WIDTH = RET_HEADS * RET_DK
RET_WIDTH = RET_HEADS * RET_DV
NA_HEADS = 8
NA_WIDTH = NA_HEADS * HEAD_DIM
MIX_WIDTH = RET_WIDTH + NA_WIDTH
IN_WIDTH = 2 * RET_QK_WIDTH + 2 * RET_WIDTH + 3 * NA_WIDTH
CHUNK = 128
WIN_H = 8
WIN_W = 16
QBLOCK = 128
ROPE_BASE = 10000.0
PEER_HEADS = 8
PEER_DKEY = 256
N_KEYS = 128
N_EXPERTS = N_KEYS * N_KEYS
PEER_TOPK = 16
TOKEN_BLOCK = 128
EPS = 1e-6
NEG_INF = -1e30

kernel_name = "hymba_retnet_natten_peer_prefix_dit"


def rms_norm(x, g):
    xf = x.astype(jnp.float32)
    y = xf * lax.rsqrt(jnp.mean(xf * xf, axis=-1, keepdims=True) + EPS)
    return (y * g.astype(jnp.float32)).astype(x.dtype)


def modulate(x, g, shift, scale):
    return rms_norm(x, g) * (1 + scale) + shift


def adaln(cvec, w_ada, b_ada):
    m = jax.nn.silu(cvec) @ w_ada + b_ada
    return jnp.split(m, 6, axis=-1)


def heads(x, n_heads):
    B, T, _ = x.shape
    return x.reshape(B, T, n_heads, -1)


def project_in(h, w_in):
    proj = h @ w_in
    cuts = np.cumsum([RET_QK_WIDTH, RET_QK_WIDTH, RET_WIDTH, RET_WIDTH, NA_WIDTH, NA_WIDTH]).tolist()
    return jnp.split(proj, cuts, axis=-1)


def rope_2d(x):
    T = x.shape[1]
    t = jnp.arange(T)
    rows = (t // GRID_W).astype(jnp.float32)
    cols = (t % GRID_W).astype(jnp.float32)
    half = RET_DK // 2
    n_freq = half // 2
    freqs = ROPE_BASE ** (-jnp.arange(n_freq, dtype=jnp.float32) / n_freq)

    def rot(xh, pos):
        ang = pos[:, None] * freqs[None, :]
        cos = jnp.cos(ang)[None, :, None, :]
        sin = jnp.sin(ang)[None, :, None, :]
        x1, x2 = xh[..., :n_freq], xh[..., n_freq:]
        return jnp.concatenate([x1 * cos - x2 * sin, x1 * sin + x2 * cos], axis=-1)

    out = jnp.concatenate([rot(x[..., :half], rows), rot(x[..., half:], cols)], axis=-1)
    return out.astype(x.dtype)


def retention_scan(q, k, v, decay_logit, s0, strict):
    B, T, H, dk = q.shape
    dv = v.shape[-1]
    n = T // CHUNK
    lg = jax.nn.log_sigmoid(decay_logit.astype(jnp.float32))
    pos = jnp.arange(CHUNK, dtype=jnp.float32)
    diff = pos[:, None] - pos[None, :]
    mask = (diff > 0) if strict else (diff >= 0)
    dmat = jnp.where(mask[None], jnp.exp(lg[:, None, None] * jnp.maximum(diff, 0.0)[None]), 0.0)
    xi = jnp.exp(lg[:, None] * (pos + 1.0)[None])
    zeta = jnp.exp(lg[:, None] * (CHUNK - 1.0 - pos)[None])
    cdec = jnp.exp(lg * CHUNK)

    def chunks(a):
        return a.astype(jnp.float32).reshape(B, n, CHUNK, H, a.shape[-1]).transpose(1, 0, 3, 2, 4)

    qs, ks, vs = chunks(q), chunks(k) * (dk ** -0.5), chunks(v)

    def step(S, inp):
        qc, kc, vc = inp
        sc = jnp.einsum('bhnd,bhmd->bhnm', qc, kc) * dmat[None]
        inner = jnp.einsum('bhnm,bhme->bhne', sc, vc)
        cross = jnp.einsum('bhnd,bhde->bhne', qc, S) * xi[None, :, :, None]
        S_new = S * cdec[None, :, None, None] + jnp.einsum('bhmd,bhme->bhde', kc * zeta[None, :, :, None], vc)
        return S_new, inner + cross

    s_fin, out = lax.scan(step, s0.astype(jnp.float32), (qs, ks, vs))
    out = out.transpose(1, 0, 3, 2, 4).reshape(B, T, H, dv)
    return out, s_fin


def bidir_retention(q, k, v, logit_f, logit_b, s0_f, s0_b):
    y_f, s_f = retention_scan(q, k, v, logit_f, s0_f, False)
    y_b, s_b = retention_scan(q[:, ::-1], k[:, ::-1], v[:, ::-1], logit_b, s0_b, True)
    return y_f + y_b[:, ::-1], s_f, s_b


def retention_output(y, g, gn_g):
    B, T = y.shape[:2]
    yn = y * lax.rsqrt(jnp.mean(y * y, axis=-1, keepdims=True) + EPS)
    yn = yn * gn_g.astype(jnp.float32).reshape(RET_HEADS, RET_DV)
    return (jax.nn.silu(g.astype(jnp.float32)) * yn.reshape(B, T, RET_WIDTH)).astype(g.dtype)


def dense_context_attention(q, k, v):
    B, T, H, d = q.shape
    qb = q.reshape(B, T // QBLOCK, QBLOCK, H, d).transpose(1, 0, 2, 3, 4)

    def blk(qi):
        s = jnp.einsum('bqhd,bkhd->bhqk', qi, k).astype(jnp.float32) * (d ** -0.5)
        p = jax.nn.softmax(s, axis=-1).astype(v.dtype)
        return jnp.einsum('bhqk,bkhd->bqhd', p, v)

    o = lax.map(blk, qb)
    return o.transpose(1, 0, 2, 3, 4).reshape(B, T, H, d)


def neighbourhood_attention(q, k, v, k_ctx, v_ctx, rpb):
    B, T, H, d = q.shape
    rows = T // GRID_W
    kh = min(WIN_H, rows)
    n_win = kh * GRID_W
    qg = q.reshape(B, rows, GRID_W, H, d)
    kg = k.reshape(B, rows, GRID_W, H, d)
    vg = v.reshape(B, rows, GRID_W, H, d)
    kcol = jnp.tile(jnp.arange(GRID_W), kh)
    krow_off = jnp.repeat(jnp.arange(kh), GRID_W)
    qcol = jnp.arange(GRID_W)
    cstart = jnp.clip(qcol - WIN_W // 2, 0, GRID_W - WIN_W)
    in_win = (kcol[None, :] >= cstart[:, None]) & (kcol[None, :] < cstart[:, None] + WIN_W)
    dc_idx = jnp.clip(kcol[None, :] - qcol[:, None] + WIN_W - 1, 0, 2 * WIN_W - 2)
    scale = d ** -0.5

    def row(r):
        rs = jnp.clip(r - kh // 2, 0, rows - kh)
        q_r = lax.dynamic_index_in_dim(qg, r, axis=1, keepdims=False)
        k_r = lax.dynamic_slice_in_dim(kg, rs, kh, axis=1).reshape(B, n_win, H, d)
        v_r = lax.dynamic_slice_in_dim(vg, rs, kh, axis=1).reshape(B, n_win, H, d)
        dr_idx = rs + krow_off - r + WIN_H - 1
        bias = rpb[:, dr_idx[None, :], dc_idx].astype(jnp.float32)
        s_win = jnp.einsum('bqhd,bkhd->bhqk', q_r, k_r).astype(jnp.float32) * scale + bias[None]
        s_win = jnp.where(in_win[None, None], s_win, NEG_INF)
        s_ctx = jnp.einsum('bqhd,bkhd->bhqk', q_r, k_ctx).astype(jnp.float32) * scale
        p = jax.nn.softmax(jnp.concatenate([s_win, s_ctx], axis=-1), axis=-1).astype(v.dtype)
        return (jnp.einsum('bhqk,bkhd->bqhd', p[..., :n_win], v_r)
                + jnp.einsum('bhqk,bkhd->bqhd', p[..., n_win:], v_ctx))

    o = lax.map(row, jnp.arange(rows))
    return o.transpose(1, 0, 2, 3, 4).reshape(B, T, H, d)


def peer(x, wq, keys, u, v):
    B, T, D = x.shape
    xt = x.reshape(-1, TOKEN_BLOCK, D)
    half = PEER_DKEY // 2

    def blk(xb):
        q = (xb @ wq).reshape(TOKEN_BLOCK, PEER_HEADS, PEER_DKEY)
        s1 = jnp.einsum('nhd,hkd->nhk', q[..., :half], keys[:, 0]).astype(jnp.float32)
        s2 = jnp.einsum('nhd,hkd->nhk', q[..., half:], keys[:, 1]).astype(jnp.float32)
        v1, i1 = lax.top_k(s1, PEER_TOPK)
        v2, i2 = lax.top_k(s2, PEER_TOPK)
        cand = (v1[..., :, None] + v2[..., None, :]).reshape(TOKEN_BLOCK, PEER_HEADS, PEER_TOPK * PEER_TOPK)
        cidx = (i1[..., :, None] * N_KEYS + i2[..., None, :]).reshape(TOKEN_BLOCK, PEER_HEADS, PEER_TOPK * PEER_TOPK)
        top, sel = lax.top_k(cand, PEER_TOPK)
        eidx = jnp.take_along_axis(cidx, sel, axis=-1)
        gate = jax.nn.softmax(top, axis=-1).astype(x.dtype)
        act = jax.nn.gelu(jnp.einsum('nd,nhkd->nhk', xb, u[eidx]))
        return jnp.einsum('nhk,nhkd->nd', gate * act, v[eidx])

    return lax.map(blk, xt).reshape(B, T, D)


def context_layer(x, c_ctx, w_ada, b_ada, norm1_g, norm2_g, w_in, ret_decay_f, ret_decay_b,
                  ret_gn_g, na_qn_g, na_kn_g, w_out, peer_wq, peer_keys, peer_u, peer_v):
    B, T, _ = x.shape
    sh1, sc1, g1, sh2, sc2, g2 = adaln(c_ctx, w_ada, b_ada)
    h = modulate(x, norm1_g, sh1, sc1)
    rq, rk, rv, rg, nq, nk, nv = project_in(h, w_in)
    zeros = jnp.zeros((B, RET_HEADS, RET_DK, RET_DV), jnp.float32)
    y_r, s_f, s_b = bidir_retention(heads(rq, RET_HEADS), heads(rk, RET_HEADS), heads(rv, RET_HEADS),
                                    ret_decay_f, ret_decay_b, zeros, zeros)
    o_r = retention_output(y_r, rg, ret_gn_g)
    qn = rms_norm(heads(nq, NA_HEADS), na_qn_g)
    kn = rms_norm(heads(nk, NA_HEADS), na_kn_g)
    vn = heads(nv, NA_HEADS)
    o_n = dense_context_attention(qn, kn, vn).reshape(B, T, NA_WIDTH)
    x = x + g1 * (jnp.concatenate([o_r, o_n], axis=-1) @ w_out)
    x = x + g2 * peer(modulate(x, norm2_g, sh2, sc2), peer_wq, peer_keys, peer_u, peer_v)
    state = jnp.stack([s_f, s_b], axis=1)
    return x, kn, vn, state


def latent_layer(x, c, k_ctx, v_ctx, state, w_ada, b_ada, norm1_g, norm2_g, w_in, ret_decay_f,
                 ret_decay_b, ret_gn_g, na_qn_g, na_kn_g, na_rpb, w_out, peer_wq, peer_keys, peer_u, peer_v):
    B, T, _ = x.shape
    sh1, sc1, g1, sh2, sc2, g2 = [m[:, None, :] for m in adaln(c, w_ada, b_ada)]
    h = modulate(x, norm1_g, sh1, sc1)
    rq, rk, rv, rg, nq, nk, nv = project_in(h, w_in)
    y_r, _, _ = bidir_retention(rope_2d(heads(rq, RET_HEADS)), rope_2d(heads(rk, RET_HEADS)),
                                heads(rv, RET_HEADS), ret_decay_f, ret_decay_b,
                                state[:, 0], state[:, 1])
    o_r = retention_output(y_r, rg, ret_gn_g)
    qn = rms_norm(heads(nq, NA_HEADS), na_qn_g)
    kn = rms_norm(heads(nk, NA_HEADS), na_kn_g)
    vn = heads(nv, NA_HEADS)
    o_n = neighbourhood_attention(qn, kn, vn, k_ctx, v_ctx, na_rpb).reshape(B, T, NA_WIDTH)
    x = x + g1 * (jnp.concatenate([o_r, o_n], axis=-1) @ w_out)
    x = x + g2 * peer(modulate(x, norm2_g, sh2, sc2), peer_wq, peer_keys, peer_u, peer_v)
    return x


def setup_inputs(seed: int = 0) -> dict:
    key = jax.random.key(seed)
    ks = jax.random.split(key, 24)
    f32 = jnp.float32
    nrm = lambda k, shape, s: jax.random.normal(k, shape, f32) * s
    base_logit = np.log(2.0 ** (5.0 + np.arange(RET_HEADS)) - 1.0).astype(np.float32)
    base_logit = jnp.asarray(base_logit)[None, :]
    return {
        "x_prompt": nrm(ks[0], (BATCH, SEQ, D_MODEL), 1.0),
        "x_sample": nrm(ks[1], (DEC_BATCH, DEC_SEQ, D_MODEL), 1.0),
        "cache_na_k": nrm(ks[2], (DEC_BATCH, DEPTH, PAST_LEN, NA_HEADS, HEAD_DIM), 1.0),
        "cache_na_v": nrm(ks[3], (DEC_BATCH, DEPTH, PAST_LEN, NA_HEADS, HEAD_DIM), 1.0),
        "state_ret": nrm(ks[4], (DEC_BATCH, DEPTH, 2, RET_HEADS, RET_DK, RET_DV), 0.5),
        "c": nrm(ks[5], (DEC_BATCH, D_MODEL), 1.0),
        "c_ctx": nrm(ks[6], (D_MODEL,), 1.0),
        "w_ada": nrm(ks[7], (DEPTH, D_MODEL, 6 * D_MODEL), 0.5 * D_MODEL ** -0.5),
        "b_ada": nrm(ks[8], (DEPTH, 6 * D_MODEL), 0.01),
        "norm1_g": 1.0 + nrm(ks[9], (DEPTH, D_MODEL), 0.02),
        "norm2_g": 1.0 + nrm(ks[10], (DEPTH, D_MODEL), 0.02),
        "w_in": nrm(ks[11], (DEPTH, D_MODEL, IN_WIDTH), D_MODEL ** -0.5),
        "ret_decay_f": base_logit + nrm(ks[12], (DEPTH, RET_HEADS), 0.1),
        "ret_decay_b": base_logit + nrm(ks[13], (DEPTH, RET_HEADS), 0.1),
        "ret_gn_g": 1.0 + nrm(ks[14], (DEPTH, RET_WIDTH), 0.02),
        "na_qn_g": 1.0 + nrm(ks[15], (DEPTH, HEAD_DIM), 0.02),
        "na_kn_g": 1.0 + nrm(ks[16], (DEPTH, HEAD_DIM), 0.02),
        "na_rpb": nrm(ks[17], (DEPTH, NA_HEADS, 2 * WIN_H - 1, 2 * WIN_W - 1), 0.1),
        "w_out": nrm(ks[18], (DEPTH, MIX_WIDTH, D_MODEL), MIX_WIDTH ** -0.5),
        "peer_wq": nrm(ks[19], (DEPTH, D_MODEL, PEER_HEADS * PEER_DKEY), D_MODEL ** -0.5),
        "peer_keys": nrm(ks[20], (DEPTH, PEER_HEADS, 2, N_KEYS, PEER_DKEY // 2), (PEER_DKEY // 2) ** -0.5),
        "peer_u": nrm(ks[21], (DEPTH, N_EXPERTS, D_MODEL), D_MODEL ** -0.5),
        "peer_v": nrm(ks[22], (DEPTH, N_EXPERTS, D_MODEL), (PEER_HEADS * PEER_TOPK) ** -0.5),
    }


def reference(x_prompt, x_sample, cache_na_k, cache_na_v, state_ret, c, c_ctx, w_ada, b_ada,
              norm1_g, norm2_g, w_in, ret_decay_f, ret_decay_b, ret_gn_g, na_qn_g, na_kn_g,
              na_rpb, w_out, peer_wq, peer_keys, peer_u, peer_v):
    y_p = x_prompt
    y_s = x_sample
    new_k, new_v, new_s = [], [], []
    for l in range(DEPTH):
        y_p, k_l, v_l, s_l = context_layer(
            y_p, c_ctx, w_ada[l], b_ada[l], norm1_g[l], norm2_g[l], w_in[l], ret_decay_f[l],
            ret_decay_b[l], ret_gn_g[l], na_qn_g[l], na_kn_g[l], w_out[l], peer_wq[l],
            peer_keys[l], peer_u[l], peer_v[l])
        new_k.append(k_l)
        new_v.append(v_l)
        new_s.append(s_l)
        y_s = latent_layer(
            y_s, c, cache_na_k[:, l], cache_na_v[:, l], state_ret[:, l], w_ada[l], b_ada[l],
            norm1_g[l], norm2_g[l], w_in[l], ret_decay_f[l], ret_decay_b[l], ret_gn_g[l],
            na_qn_g[l], na_kn_g[l], na_rpb[l], w_out[l], peer_wq[l], peer_keys[l], peer_u[l], peer_v[l])
    new_na_k = jnp.stack(new_k, axis=1)
    new_na_v = jnp.stack(new_v, axis=1)
    new_state_ret = jnp.stack(new_s, axis=1)
    return (y_p, y_s, new_na_k, new_na_v, new_state_ret)
```

```cpp
#include <hip/hip_runtime.h>
#include <hip/hip_cooperative_groups.h>
#include <cstdio>
#include <cstdint>
namespace cg = cooperative_groups;

#define DEV __device__ __forceinline__
typedef unsigned short bf16_t;
typedef short bf16x8 __attribute__((ext_vector_type(8)));
typedef float f32x4 __attribute__((ext_vector_type(4)));
typedef unsigned u32x4 __attribute__((ext_vector_type(4)));
typedef unsigned u32x2 __attribute__((ext_vector_type(2)));
typedef __bf16 bf16x2_t __attribute__((ext_vector_type(2)));
typedef float f32x2 __attribute__((ext_vector_type(2)));

constexpr int NTOK = 12288, NCTX = 4096;
constexpr float EPSF = 1e-6f, LOG2E = 1.4426950408889634f;

struct Params {
  const float* x_prompt; const float* x_sample; const float* cache_k; const float* cache_v; const float* state;
  const float* c; const float* c_ctx; const float* w_ada; const float* b_ada; const float* norm1_g; const float* norm2_g;
  const float* w_in; const float* decay_f; const float* decay_b; const float* gn_g; const float* qn_g; const float* kn_g;
  const float* rpb; const float* w_out; const float* wq; const float* keys; const float* pu; const float* pv;
  float* out; unsigned char* ws;
};

constexpr size_t OFF_BAR   = 0;
constexpr size_t OFF_MODP  = 16384;
constexpr size_t OFF_MODS  = OFF_MODP + 8ull * 9 * 6144 * 4;
constexpr size_t OFF_ROPE  = OFF_MODS + 9ull * 6144 * 4;
constexpr size_t OFF_WIN   = OFF_ROPE + 8192;
constexpr size_t OFF_WOUT  = OFF_WIN + 3584ull * 1024 * 2;
constexpr size_t OFF_WQ    = OFF_WOUT + 1024ull * 1024 * 2;
constexpr size_t OFF_KEYS  = OFF_WQ + 2048ull * 1024 * 2;
constexpr size_t OFF_U     = OFF_KEYS + 262144ull * 2;
constexpr size_t OFF_V     = OFF_U + 16384ull * 1024 * 2;
constexpr size_t OFF_SU    = OFF_U + 16384ull * 1024;
constexpr size_t OFF_SV    = OFF_V + 16384ull * 1024;
constexpr size_t OFF_CK    = OFF_V + 16384ull * 1024 * 2;
constexpr size_t OFF_CVT   = OFF_CK + 1048576ull * 2;
constexpr size_t OFF_S0T   = OFF_CVT + 1048576ull * 2;
constexpr size_t OFF_ACT   = OFF_S0T + 524288ull * 2;
constexpr size_t OFF_RQ    = OFF_ACT + 12288ull * 1024 * 2;
constexpr size_t OFF_RK    = OFF_RQ + 12288ull * 512 * 2;
constexpr size_t OFF_RG    = OFF_RK + 12288ull * 512 * 2;
constexpr size_t OFF_NQ    = OFF_RG + 12288ull * 512 * 2;
constexpr size_t OFF_NK    = OFF_NQ + 12288ull * 512 * 2;
constexpr size_t OFF_RVT   = OFF_NK + 12288ull * 512 * 2;
constexpr size_t OFF_NVT   = OFF_RVT + 6291456ull * 2;
constexpr size_t OFF_KT    = OFF_NVT + 6291456ull * 2;
constexpr size_t OFF_H8    = OFF_KT + 2097152ull * 2;
constexpr size_t OFF_SH    = OFF_H8 + 12288ull * 1024;
constexpr size_t OFF_COEF  = OFF_SH + 12288ull * 4;
constexpr size_t OFF_END   = OFF_COEF + 12288ull * 128 * 4;
constexpr size_t OFF_PART  = OFF_RQ;
constexpr size_t OFF_QP    = OFF_RQ;
constexpr size_t OFF_LE    = OFF_RVT;
constexpr size_t OFF_LG    = OFF_NVT;
static_assert(OFF_END < 256ull * 1024 * 1024, "workspace too large");
constexpr size_t LAT_VT = 2097152;

constexpr size_t OUT_NAK = 12582912, OUT_NAV = 14680064, OUT_ST = 16777216;

DEV unsigned pk_bf16(float lo, float hi) { bf16x2_t v; v.x = (__bf16)lo; v.y = (__bf16)hi; return __builtin_bit_cast(unsigned, v); }
DEV float bf_lo(unsigned u) { return __uint_as_float(u << 16); }
DEV float bf_hi(unsigned u) { return __uint_as_float(u & 0xffff0000u); }
DEV float bf2f(bf16_t v) { return __uint_as_float(((unsigned)v) << 16); }
DEV bf16_t f2bf(float f) { return __builtin_bit_cast(bf16_t, (__bf16)f); }
DEV float dot2(unsigned a, unsigned b, float c) { return __builtin_amdgcn_fdot2_f32_bf16(__builtin_bit_cast(bf16x2_t, a), __builtin_bit_cast(bf16x2_t, b), c, false); }
DEV f32x4 mfma16(bf16x8 a, bf16x8 b, f32x4 c) { return __builtin_amdgcn_mfma_f32_16x16x32_bf16(a, b, c, 0, 0, 0); }
DEV float ex2(float x) { return __builtin_amdgcn_exp2f(x); }
DEV float siluf(float x) { return x / (1.f + __expf(-x)); }
DEV float gelu_tanh(float x) { const float z = 0.7978845608028654f * (x + 0.044715f * x * x * x); const float t = 1.f - 2.f / (__expf(2.f * z) + 1.f); return 0.5f * x * (1.f + t); }
DEV int mod_row(int m) { return m < NCTX ? 0 : 1 + ((m - NCTX) >> 10); }
DEV const float* xrow(const Params& p, int m) { return m < NCTX ? p.x_prompt + (size_t)m * 1024 : p.x_sample + (size_t)(m - NCTX) * 1024; }
DEV float wave_sum(float v) { v += __shfl_xor(v, 32); v += __shfl_xor(v, 16); v += __shfl_xor(v, 8); v += __shfl_xor(v, 4); v += __shfl_xor(v, 2); v += __shfl_xor(v, 1); return v; }
DEV float row16_sum(float v) { v += __shfl_xor(v, 8); v += __shfl_xor(v, 4); v += __shfl_xor(v, 2); v += __shfl_xor(v, 1); return v; }
DEV bf16x8 mk8(u32x4 v) { return __builtin_bit_cast(bf16x8, v); }
DEV int tidx() { int t = threadIdx.x; asm volatile("" : "+v"(t)); return t; }

DEV unsigned pack_i8x4(float a, float b, float c, float d, float sc) {
  const int ia = max(-127, min(127, __float2int_rn(a * sc))), ib = max(-127, min(127, __float2int_rn(b * sc)));
  const int ic = max(-127, min(127, __float2int_rn(c * sc))), id = max(-127, min(127, __float2int_rn(d * sc)));
  return (unsigned)(ia & 255) | ((unsigned)(ib & 255) << 8) | ((unsigned)(ic & 255) << 16) | ((unsigned)(id & 255) << 24);
}
template <int N> DEV void bitonic_sort_desc(float (&v)[N]) {
#pragma unroll
  for (int k = 2; k <= N; k <<= 1)
#pragma unroll
    for (int j = k >> 1; j > 0; j >>= 1)
#pragma unroll
      for (int i = 0; i < N; ++i) { const int l = i ^ j; if (l > i) { const bool desc = ((i & k) == 0); const float a = v[i], b = v[l]; const float hi = fmaxf(a, b), lo = fminf(a, b); v[i] = desc ? hi : lo; v[l] = desc ? lo : hi; } }
}
template <int N> DEV void bitonic_merge_desc(float (&v)[N]) {
#pragma unroll
  for (int j = N >> 1; j > 0; j >>= 1)
#pragma unroll
    for (int i = 0; i < N; ++i) { const int l = i ^ j; if (l > i) { const float a = v[i], b = v[l]; v[i] = fmaxf(a, b); v[l] = fminf(a, b); } }
}
DEV void top16_merge(float (&a)[16], const float (&b)[16]) {
#pragma unroll
  for (int i = 0; i < 16; ++i) a[i] = fmaxf(a[i], b[15 - i]);
  bitonic_merge_desc<16>(a);
}

DEV void tr_tile(const float* src, int ss, bf16_t* dst, int ds, int r0, int c0, float* tile) {
  const int tid = threadIdx.x;
  __syncthreads();
#pragma unroll
  for (int i = 0; i < 8; ++i) { const int idx = tid + 512 * i, r = idx >> 6, c = idx & 63; tile[r * 65 + c] = src[(size_t)(r0 + r) * ss + c0 + c]; }
  __syncthreads();
#pragma unroll
  for (int i = 0; i < 4; ++i) { const int idx = tid + 512 * i, cc = idx >> 5, rr = (idx & 31) * 2;
    *(unsigned*)(dst + (size_t)(c0 + cc) * ds + r0 + rr) = pk_bf16(tile[rr * 65 + cc], tile[(rr + 1) * 65 + cc]); }
}
DEV void tr_block256(const float* src, int ss, bf16_t* dst, int ds, int r0, int c0, unsigned char* tile) {
  const int tid = threadIdx.x;
  float v[32];
#pragma unroll
  for (int i = 0; i < 32; ++i) { const int idx = tid + 512 * i, r = idx >> 6, c = idx & 63; v[i] = src[(size_t)(r0 + r) * ss + c0 + c]; }
  __syncthreads();
#pragma unroll
  for (int i = 0; i < 32; ++i) { const int idx = tid + 512 * i, r = idx >> 6, c = idx & 63; *(bf16_t*)(tile + c * 528 + r * 2) = f2bf(v[i]); }
  __syncthreads();
#pragma unroll
  for (int i = 0; i < 4; ++i) { const int idx = tid + 512 * i, cc = idx >> 5, ch = idx & 31;
    *(u32x4*)(dst + (size_t)(c0 + cc) * ds + r0 + ch * 8) = *(const u32x4*)(tile + cc * 528 + ch * 16); }
}
DEV void cvt_chunk(const float* src, bf16_t* dst, size_t base) {
  const size_t i = base + (size_t)threadIdx.x * 8;
  const float4 a = *(const float4*)(src + i), b = *(const float4*)(src + i + 4);
  u32x4 o; o.x = pk_bf16(a.x, a.y); o.y = pk_bf16(a.z, a.w); o.z = pk_bf16(b.x, b.y); o.w = pk_bf16(b.z, b.w);
  *(u32x4*)(dst + i) = o;
}
DEV void cvt_row_fp8(const float* src, unsigned char* dst, float* inv_scale, int row, int lane) {
  const float* s = src + (size_t)row * 1024 + lane * 16;
  float4 v[4]; float am = 0.f;
#pragma unroll
  for (int i = 0; i < 4; ++i) { v[i] = *(const float4*)(s + i * 4); am = fmaxf(am, fmaxf(fmaxf(fabsf(v[i].x), fabsf(v[i].y)), fmaxf(fabsf(v[i].z), fabsf(v[i].w)))); }
#pragma unroll
  for (int o = 32; o > 0; o >>= 1) am = fmaxf(am, __shfl_xor(am, o));
  const unsigned sb = __float_as_uint(240.f / fmaxf(am, 1e-30f)) & 0x7F800000u;
  const unsigned sbc = sb > 0x5F000000u ? 0x5F000000u : sb;
  const float sc = __uint_as_float(sbc);
  u32x4 o4; unsigned w[4];
#pragma unroll
  for (int i = 0; i < 4; ++i) { int t = __builtin_amdgcn_cvt_pk_fp8_f32(v[i].x * sc, v[i].y * sc, 0, false); t = __builtin_amdgcn_cvt_pk_fp8_f32(v[i].z * sc, v[i].w * sc, t, true); w[i] = (unsigned)t; }
  o4.x = w[0]; o4.y = w[1]; o4.z = w[2]; o4.w = w[3];
  *(u32x4*)(dst + ((size_t)(lane >> 3) * 16384 + row) * 128 + (lane & 7) * 16) = o4;
  if (lane == 0) inv_scale[row] = __uint_as_float(0x7F000000u - sbc);
}
DEV void cvt_row_i8(const float* src, unsigned char* dst, float* inv_scale, int row, int lane) {
  const float* s = src + (size_t)row * 1024 + lane * 16;
  float4 v[4]; float am = 0.f;
#pragma unroll
  for (int i = 0; i < 4; ++i) { v[i] = *(const float4*)(s + i * 4); am = fmaxf(am, fmaxf(fmaxf(fabsf(v[i].x), fabsf(v[i].y)), fmaxf(fabsf(v[i].z), fabsf(v[i].w)))); }
#pragma unroll
  for (int o = 32; o > 0; o >>= 1) am = fmaxf(am, __shfl_xor(am, o));
  am = fmaxf(am, 1e-30f);
  const float sc = 127.f / am;
  u32x4 o4;
  o4.x = pack_i8x4(v[0].x, v[0].y, v[0].z, v[0].w, sc); o4.y = pack_i8x4(v[1].x, v[1].y, v[1].z, v[1].w, sc);
  o4.z = pack_i8x4(v[2].x, v[2].y, v[2].z, v[2].w, sc); o4.w = pack_i8x4(v[3].x, v[3].y, v[3].z, v[3].w, sc);
  *(u32x4*)(dst + ((size_t)(lane >> 3) * 16384 + row) * 128 + (lane & 7) * 16) = o4;
  if (lane == 0) inv_scale[row] = am * (1.f / 127.f);
}
DEV void phase0(const Params& p, unsigned char* lds) {
  const int tid = threadIdx.x;
  float* fl = (float*)lds;
  constexpr int U_ADA = 96, U_WIN = 224, U_WOUT = 64, U_WQ = 128, U_CV = 256, U_ST = 128, U_ROPE = 1, U_PU = 512, U_PV = 512, U_KEYS = 64, U_CK = 256;
  constexpr int TOTAL = U_ADA + U_WIN + U_WOUT + U_WQ + U_CV + U_ST + U_ROPE + U_PU + U_PV + U_KEYS + U_CK;
  for (int unit = blockIdx.x; unit < TOTAL; unit += gridDim.x) {
    int u = unit;
    if (u < U_ADA) {
      const int ks = u / 12, cb = u % 12;
      __syncthreads();
      for (int idx = tid; idx < 9 * 128; idx += 512) { const int r = idx >> 7, k = ks * 128 + (idx & 127); const float cv = (r == 0) ? p.c_ctx[k] : p.c[(r - 1) * 1024 + k]; fl[idx] = siluf(cv); }
      __syncthreads();
      const int n = cb * 512 + tid; float acc[9];
#pragma unroll
      for (int r = 0; r < 9; ++r) acc[r] = 0.f;
      const float* wp = p.w_ada + (size_t)(ks * 128) * 6144 + n;
#pragma unroll 1
      for (int k0 = 0; k0 < 128; k0 += 16) {
        float wv[16];
#pragma unroll
        for (int i = 0; i < 16; ++i) wv[i] = wp[(size_t)(k0 + i) * 6144];
#pragma unroll
        for (int i = 0; i < 16; ++i)
#pragma unroll
          for (int r = 0; r < 9; ++r) acc[r] += fl[r * 128 + k0 + i] * wv[i]; }
      float* mp = (float*)(p.ws + OFF_MODP);
#pragma unroll
      for (int r = 0; r < 9; ++r) mp[(size_t)(ks * 9 + r) * 6144 + n] = acc[r];
      continue;
    }
    u -= U_ADA;
    if (u < U_WIN) { tr_block256(p.w_in, 3584, (bf16_t*)(p.ws + OFF_WIN), 1024, (u / 56) * 256, (u % 56) * 64, lds); continue; }
    u -= U_WIN;
    if (u < U_WOUT) { tr_block256(p.w_out, 1024, (bf16_t*)(p.ws + OFF_WOUT), 1024, (u / 16) * 256, (u % 16) * 64, lds); continue; }
    u -= U_WOUT;
    if (u < U_WQ) { tr_block256(p.wq, 2048, (bf16_t*)(p.ws + OFF_WQ), 1024, (u / 32) * 256, (u % 32) * 64, lds); continue; }
    u -= U_WQ;
    if (u < U_CV) { const int b = u >> 5, t = u & 31; tr_tile(p.cache_v + (size_t)b * 131072, 512, (bf16_t*)(p.ws + OFF_CVT) + (size_t)b * 131072, 256, (t >> 3) * 64, (t & 7) * 64, fl); continue; }
    u -= U_CV;
    if (u < U_ST) { tr_tile(p.state + (size_t)u * 4096, 64, (bf16_t*)(p.ws + OFF_S0T) + (size_t)u * 4096, 64, 0, 0, fl); continue; }
    u -= U_ST;
    if (u < U_ROPE) {
      float2* rt = (float2*)(p.ws + OFF_ROPE);
      for (int idx = tid; idx < 1024; idx += 512) { const int pos = idx >> 4, i = idx & 15; const float fr = exp2f(-(float)i * (13.287712379549449f / 16.f)); const float ang = (float)pos * fr; rt[idx] = make_float2(cosf(ang), sinf(ang)); }
      continue;
    }
    u -= U_ROPE;
    if (u < U_PU) {
#pragma unroll
      for (int i = 0; i < 4; ++i) cvt_row_i8(p.pu, p.ws + OFF_U, (float*)(p.ws + OFF_SU), u * 32 + i * 8 + (tid >> 6), tid & 63);
      continue; }
    u -= U_PU;
    if (u < U_PV) {
#pragma unroll
      for (int i = 0; i < 4; ++i) cvt_row_fp8(p.pv, p.ws + OFF_V, (float*)(p.ws + OFF_SV), u * 32 + i * 8 + (tid >> 6), tid & 63);
      continue; }
    u -= U_PV;
    if (u < U_KEYS) { cvt_chunk(p.keys, (bf16_t*)(p.ws + OFF_KEYS), (size_t)u * 4096); continue; }
    u -= U_KEYS;
    cvt_chunk(p.cache_k, (bf16_t*)(p.ws + OFF_CK), (size_t)u * 4096);
  }
}

template <int WHICH> DEV void phase_mod(const Params& p, unsigned char* lds) {
  const int tid = threadIdx.x, lane = tid & 63, w = tid >> 6;
  float* shs = (float*)lds; float* scs = shs + 1024;
  const float* mp = (const float*)(p.ws + OFF_MODP);
  float* mods = (float*)(p.ws + OFF_MODS);
  if (WHICH == 0) {
    for (int u = blockIdx.x; u < 108; u += gridDim.x) { const int r = u / 12, n = (u % 12) * 512 + tid; float s = p.b_ada[n];
#pragma unroll
      for (int ks = 0; ks < 8; ++ks) s += mp[(size_t)(ks * 9 + r) * 6144 + n];
      mods[r * 6144 + n] = s; }
  }
  const int G = gridDim.x; const int q0 = (int)((long)blockIdx.x * 768 / G), q1 = (int)((long)(blockIdx.x + 1) * 768 / G);
  int cur = -1;
  const float* gptr = WHICH == 0 ? p.norm1_g : p.norm2_g;
  bf16_t* act = (bf16_t*)(p.ws + OFF_ACT);
  for (int qb = q0; qb < q1; qb += 3) {
    float4 va[3][2][4];
#pragma unroll
    for (int gi = 0; gi < 3; ++gi) { const int q = min(qb + gi, q1 - 1);
#pragma unroll
      for (int rr = 0; rr < 2; ++rr) { const int m = q * 16 + w + rr * 8; const float* xr = WHICH == 0 ? xrow(p, m) : p.out + (size_t)m * 1024;
#pragma unroll
        for (int i = 0; i < 4; ++i) va[gi][rr][i] = *(const float4*)(xr + i * 256 + lane * 4); } }
#pragma unroll
    for (int gi = 0; gi < 3; ++gi) {
      if (qb + gi >= q1) break;
      const int q = qb + gi;
      const int m0 = q * 16, mr = mod_row(m0);
      if (mr != cur) {
        __syncthreads();
        for (int n = tid; n < 1024; n += 512) {
          float sh, sc;
          if (WHICH == 0) { sh = p.b_ada[n]; sc = p.b_ada[1024 + n];
#pragma unroll
            for (int ks = 0; ks < 8; ++ks) { sh += mp[(size_t)(ks * 9 + mr) * 6144 + n]; sc += mp[(size_t)(ks * 9 + mr) * 6144 + 1024 + n]; } }
          else { sh = mods[mr * 6144 + 3 * 1024 + n]; sc = mods[mr * 6144 + 4 * 1024 + n]; }
          shs[n] = sh; scs[n] = 1.f + sc; }
        __syncthreads(); cur = mr;
      }
#pragma unroll
      for (int rr = 0; rr < 2; ++rr) {
        const int m = m0 + w + rr * 8;
        float4 (&v)[4] = va[gi][rr]; float ss = 0.f;
#pragma unroll
        for (int i = 0; i < 4; ++i) ss += v[i].x * v[i].x + v[i].y * v[i].y + v[i].z * v[i].z + v[i].w * v[i].w;
        ss = wave_sum(ss);
        const float rstd = rsqrtf(ss * (1.f / 1024.f) + EPSF);
#pragma unroll
        for (int i = 0; i < 4; ++i) { const int n = i * 256 + lane * 4;
          const float4 g4 = *(const float4*)(gptr + n), s4 = *(const float4*)(shs + n), c4 = *(const float4*)(scs + n);
          const float h0 = v[i].x * rstd * g4.x * c4.x + s4.x, h1 = v[i].y * rstd * g4.y * c4.y + s4.y, h2 = v[i].z * rstd * g4.z * c4.z + s4.z, h3 = v[i].w * rstd * g4.w * c4.w + s4.w;
          u32x2 o; o.x = pk_bf16(h0, h1); o.y = pk_bf16(h2, h3);
          *(u32x2*)(act + (size_t)m * 1024 + n) = o;
          if (WHICH == 1) { v[i].x = h0; v[i].y = h1; v[i].z = h2; v[i].w = h3; } }
        if (WHICH == 1) {
          float am = 0.f;
#pragma unroll
          for (int i = 0; i < 4; ++i) am = fmaxf(am, fmaxf(fmaxf(fabsf(v[i].x), fabsf(v[i].y)), fmaxf(fabsf(v[i].z), fabsf(v[i].w))));
#pragma unroll
          for (int o = 32; o > 0; o >>= 1) am = fmaxf(am, __shfl_xor(am, o));
          am = fmaxf(am, 1e-30f); const float qs = 127.f / am;
          unsigned char* h8 = p.ws + OFF_H8;
#pragma unroll
          for (int i = 0; i < 4; ++i) *(unsigned*)(h8 + ((size_t)(2 * i + (lane >> 5)) * 12288 + m) * 128 + (lane & 31) * 4) = pack_i8x4(v[i].x, v[i].y, v[i].z, v[i].w, qs);
          if (lane == 0) ((float*)(p.ws + OFF_SH))[m] = am * (1.f / 127.f);
        }
      }
    }
  }
}

template <int MI> DEV void epi_inproj(const Params& p, f32x4 (&acc)[MI][4], int mb, int nb, int lane) {
  const int r = lane & 15, g = lane >> 4;
  const int region = nb >> 9, h = (nb >> 6) & 7;
  if (region <= 1) {
    const float2* rt = (const float2*)(p.ws + OFF_ROPE);
    const float sc = region == 1 ? 0.125f : 1.f;
    bf16_t* dst = (bf16_t*)(p.ws + (region == 0 ? OFF_RQ : OFF_RK));
    bf16_t* kt = (bf16_t*)(p.ws + OFF_KT);
#pragma unroll
    for (int mi = 0; mi < MI; ++mi) {
      const int m4 = mb + mi * 16 + g * 4; const bool lat = m4 >= NCTX;
      if (lat) {
#pragma unroll
        for (int reg = 0; reg < 4; ++reg) { const int t = (m4 + reg - NCTX) & 1023; const float2 cr = rt[(t >> 6) * 16 + r], cc = rt[(t & 63) * 16 + r];
          const float a1 = acc[mi][0][reg], a2 = acc[mi][1][reg]; acc[mi][0][reg] = a1 * cr.x - a2 * cr.y; acc[mi][1][reg] = a1 * cr.y + a2 * cr.x;
          const float b1 = acc[mi][2][reg], b2 = acc[mi][3][reg]; acc[mi][2][reg] = b1 * cc.x - b2 * cc.y; acc[mi][3][reg] = b1 * cc.y + b2 * cc.x; }
      }
#pragma unroll
      for (int reg = 0; reg < 4; ++reg)
#pragma unroll
        for (int ni = 0; ni < 4; ++ni) dst[(size_t)(m4 + reg) * 512 + h * 64 + ni * 16 + r] = f2bf(acc[mi][ni][reg] * sc);
      if (region == 1 && !lat) { const int b = m4 >> 8, t = m4 & 255;
#pragma unroll
        for (int ni = 0; ni < 4; ++ni) { u32x2 o; o.x = pk_bf16(acc[mi][ni][0] * sc, acc[mi][ni][1] * sc); o.y = pk_bf16(acc[mi][ni][2] * sc, acc[mi][ni][3] * sc);
          *(u32x2*)(kt + ((size_t)(b * 8 + h) * 64 + ni * 16 + r) * 256 + t) = o; } }
    }
  } else if (region == 2 || region == 6) {
    bf16_t* vt = (bf16_t*)(p.ws + (region == 2 ? OFF_RVT : OFF_NVT));
#pragma unroll
    for (int mi = 0; mi < MI; ++mi) { const int m = mb + mi * 16 + g * 4; const bool lat = m >= NCTX;
      size_t base; int T;
      if (!lat) { base = (size_t)((m >> 8) * 8 + h) * 64 * 256 + (m & 255); T = 256; }
      else { const int ml = m - NCTX; base = LAT_VT + (size_t)((ml >> 10) * 8 + h) * 64 * 1024 + (ml & 1023); T = 1024; }
#pragma unroll
      for (int ni = 0; ni < 4; ++ni) { u32x2 o; o.x = pk_bf16(acc[mi][ni][0], acc[mi][ni][1]); o.y = pk_bf16(acc[mi][ni][2], acc[mi][ni][3]);
        *(u32x2*)(vt + base + (size_t)(ni * 16 + r) * T) = o; }
      if (region == 6 && !lat) {
#pragma unroll
        for (int reg = 0; reg < 4; ++reg)
#pragma unroll
          for (int ni = 0; ni < 4; ++ni) p.out[OUT_NAV + (size_t)(m + reg) * 512 + h * 64 + ni * 16 + r] = acc[mi][ni][reg]; } }
  } else if (region == 3) {
    bf16_t* dst = (bf16_t*)(p.ws + OFF_RG);
#pragma unroll
    for (int mi = 0; mi < MI; ++mi)
#pragma unroll
      for (int reg = 0; reg < 4; ++reg) { const int m = mb + mi * 16 + g * 4 + reg;
#pragma unroll
        for (int ni = 0; ni < 4; ++ni) dst[(size_t)m * 512 + h * 64 + ni * 16 + r] = f2bf(siluf(acc[mi][ni][reg])); }
  } else {
    const float* gp = region == 4 ? p.qn_g : p.kn_g;
    float gv[4];
#pragma unroll
    for (int ni = 0; ni < 4; ++ni) gv[ni] = gp[ni * 16 + r] * (region == 4 ? 0.125f : 1.f);
    bf16_t* dst = (bf16_t*)(p.ws + (region == 4 ? OFF_NQ : OFF_NK));
#pragma unroll
    for (int mi = 0; mi < MI; ++mi)
#pragma unroll
      for (int reg = 0; reg < 4; ++reg) { const int m = mb + mi * 16 + g * 4 + reg; const bool lat = m >= NCTX;
        float ss = 0.f;
#pragma unroll
        for (int ni = 0; ni < 4; ++ni) ss += acc[mi][ni][reg] * acc[mi][ni][reg];
        ss = row16_sum(ss);
        const float rstd = rsqrtf(ss * (1.f / 64.f) + EPSF);
#pragma unroll
        for (int ni = 0; ni < 4; ++ni) { const float y = acc[mi][ni][reg] * rstd * gv[ni];
          dst[(size_t)m * 512 + h * 64 + ni * 16 + r] = f2bf(y);
          if (region == 5 && !lat) p.out[OUT_NAK + (size_t)m * 512 + h * 64 + ni * 16 + r] = y; } }
  }
}
template <int MI> DEV void epi_outproj_prefetch(const Params& p, f32x4 (&xpre)[MI][4], int mb, int nb, int lane) {
  const int r = lane & 15, g = lane >> 4;
#pragma unroll
  for (int mi = 0; mi < MI; ++mi)
#pragma unroll
    for (int reg = 0; reg < 4; ++reg) { const float* xr = xrow(p, mb + mi * 16 + g * 4 + reg) + nb + r;
#pragma unroll
      for (int ni = 0; ni < 4; ++ni) xpre[mi][ni][reg] = xr[ni * 16]; }
}
template <int MI> DEV void epi_outproj(const Params& p, f32x4 (&acc)[MI][4], const f32x4 (&xpre)[MI][4], int mb, int nb, int lane) {
  const int r = lane & 15, g = lane >> 4;
  const float* mods = (const float*)(p.ws + OFF_MODS);
#pragma unroll
  for (int mi = 0; mi < MI; ++mi) { const int m4 = mb + mi * 16 + g * 4; const float* g1 = mods + mod_row(m4) * 6144 + 2048 + nb + r;
    float gv[4];
#pragma unroll
    for (int ni = 0; ni < 4; ++ni) gv[ni] = g1[ni * 16];
#pragma unroll
    for (int reg = 0; reg < 4; ++reg)
#pragma unroll
      for (int ni = 0; ni < 4; ++ni) p.out[(size_t)(m4 + reg) * 1024 + nb + ni * 16 + r] = xpre[mi][ni][reg] + gv[ni] * acc[mi][ni][reg]; }
}
template <int MI> DEV void epi_qp(const Params& p, f32x4 (&acc)[MI][4], int mb, int nb, int lane) {
  const int r = lane & 15, g = lane >> 4;
  bf16_t* dst = (bf16_t*)(p.ws + OFF_QP);
#pragma unroll
  for (int mi = 0; mi < MI; ++mi)
#pragma unroll
    for (int reg = 0; reg < 4; ++reg) { const int m = mb + mi * 16 + g * 4 + reg;
#pragma unroll
      for (int ni = 0; ni < 4; ++ni) dst[(size_t)m * 2048 + nb + ni * 16 + r] = f2bf(acc[mi][ni][reg]); }
}

template <int MODE, int BM> DEV void gemm_phase(const Params& p, unsigned char* lds, const bf16_t* A, const bf16_t* Bt, int N) {
  constexpr int MI = BM / 64, NA = BM / 64;
  constexpr int ABYTES = BM * 128, STAGE = ABYTES + 128 * 128;
  const int tid = tidx(), lane = tid & 63, w = tid >> 6, wm = w >> 1, wn = w & 1, r = lane & 15, g = lane >> 4;
  const int tn = N >> 7, ntiles = (NTOK / BM) * tn;
  for (int tile = blockIdx.x; tile < ntiles; tile += gridDim.x) {
    const int m0 = (tile / tn) * BM, n0 = (tile % tn) * 128;
    f32x4 acc[MI][4];
#pragma unroll
    for (int mi = 0; mi < MI; ++mi)
#pragma unroll
      for (int ni = 0; ni < 4; ++ni) acc[mi][ni] = (f32x4){0.f, 0.f, 0.f, 0.f};
    f32x4 xpre[MODE == 1 ? MI : 1][4];
    if (MODE == 1) epi_outproj_prefetch<MI>(p, (f32x4 (&)[MI][4])xpre, m0 + wm * (BM / 4), n0 + wn * 64, lane);
    const int srow = tid >> 3, lch = (tid & 7) ^ (srow & 7);
    const bf16_t* ap = A + (size_t)(m0 + srow) * 1024 + lch * 8;
    const bf16_t* bp = Bt + (size_t)(n0 + srow) * 1024 + lch * 8;
    __syncthreads();
#define GEMM_ISSUE(tt) do { unsigned char* Sn = lds + ((tt) % 3) * STAGE; \
      _Pragma("unroll") for (int i = 0; i < NA; ++i) __builtin_amdgcn_global_load_lds((const unsigned*)(ap + (size_t)i * 64 * 1024 + (tt) * 64), (__attribute__((address_space(3))) unsigned*)(Sn + i * 8192 + tid * 16), 16, 0, 0); \
      _Pragma("unroll") for (int i = 0; i < 2; ++i) __builtin_amdgcn_global_load_lds((const unsigned*)(bp + (size_t)i * 64 * 1024 + (tt) * 64), (__attribute__((address_space(3))) unsigned*)(Sn + ABYTES + i * 8192 + tid * 16), 16, 0, 0); } while (0)
    GEMM_ISSUE(0); GEMM_ISSUE(1);
    for (int t = 0; t < 16; ++t) {
      if (t < 15) { if (NA == 3) asm volatile("s_waitcnt vmcnt(5)" ::: "memory"); else asm volatile("s_waitcnt vmcnt(6)" ::: "memory"); }
      else asm volatile("s_waitcnt vmcnt(0)" ::: "memory");
      __builtin_amdgcn_s_barrier();
      asm volatile("" ::: "memory");
      if (t + 2 < 16) GEMM_ISSUE(t + 2);
      unsigned char* As = lds + (t % 3) * STAGE; unsigned char* Bs = As + ABYTES;
#pragma unroll
      for (int ks = 0; ks < 2; ++ks) {
        bf16x8 a[MI], b[4];
        const int coff = ((ks * 4 + g) ^ (r & 7)) << 4;
#pragma unroll
        for (int mi = 0; mi < MI; ++mi) a[mi] = *(const bf16x8*)(As + (wm * (BM / 4) + mi * 16 + r) * 128 + coff);
#pragma unroll
        for (int ni = 0; ni < 4; ++ni) b[ni] = *(const bf16x8*)(Bs + (wn * 64 + ni * 16 + r) * 128 + coff);
#pragma unroll
        for (int mi = 0; mi < MI; ++mi)
#pragma unroll
          for (int ni = 0; ni < 4; ++ni) acc[mi][ni] = mfma16(a[mi], b[ni], acc[mi][ni]);
      }
    }
#undef GEMM_ISSUE
    asm volatile("s_waitcnt lgkmcnt(0)" ::: "memory");
    const int mb = m0 + wm * (BM / 4), nb = n0 + wn * 64;
    if (MODE == 0) epi_inproj<MI>(p, acc, mb, nb, lane);
    else if (MODE == 1) epi_outproj<MI>(p, acc, (const f32x4 (&)[MI][4])xpre, mb, nb, lane);
    else epi_qp<MI>(p, acc, mb, nb, lane);
  }
}

namespace g8 {
constexpr int BM = 256, BK = 64, HALF = 128, HT = HALF * BK;
DEV int lds_byte(int r, int c) { const int st = (r >> 4) * 2 + (c >> 5), rr = r & 15, cc = c & 31, ob = rr * 64 + cc * 2; return st * 1024 + (ob ^ (((ob >> 9) & 1) << 5)); }
DEV void stage_rc(int b, int& R, int& C) { const int st = b / 1024, sb = b % 1024, swz = sb ^ (((sb >> 9) & 1) << 5); R = (st >> 1) * 16 + swz / 64; C = (st & 1) * 32 + (swz % 64) / 2; }
typedef f32x4 Acc[2][2][4][2];
template <int MI = 4> DEV void kloop(const bf16_t* A, const bf16_t* Bt, int K, int brow, int bcol, bf16_t* shm, Acc& acc, int tid) {
  constexpr int AH = MI * 32;
  const int wid = __builtin_amdgcn_readfirstlane(tid >> 6), lane = tid & 63, wr = wid >> 2, wc = wid & 3, fr = lane & 15, fq = lane >> 4;
#define SA(b,h) (shm+((b)*2+(h))*HT)
#define SB(b,h) (shm+(4+(b)*2+(h))*HT)
#define STAGE(P,BASE,br,kt) do{ const long _g=(long)(br)*K+(long)(kt)*BK; \
    _Pragma("unroll") for(int _i=0;_i<2;++_i){ const int _b=tid*16+_i*8192; int _r,_c; stage_rc(_b,_r,_c); \
      __builtin_amdgcn_global_load_lds((const unsigned*)((BASE)+_g+(long)_r*K+_c), (__attribute__((address_space(3))) unsigned*)((unsigned char*)(P)+_b),16,0,0);}}while(0)
#define LDA(dst,b,h) _Pragma("unroll") for(int m=0;m<MI;++m) _Pragma("unroll") for(int k=0;k<2;++k) \
    dst[m][k]=*reinterpret_cast<const bf16x8*>((const unsigned char*)SA(b,h)+lds_byte(wr*(MI*16)+m*16+fr,k*32+fq*8))
#define LDB(dst,b,h) _Pragma("unroll") for(int n=0;n<2;++n) _Pragma("unroll") for(int k=0;k<2;++k) \
    dst[n][k]=*reinterpret_cast<const bf16x8*>((const unsigned char*)SB(b,h)+lds_byte(wc*32+n*16+fr,k*32+fq*8))
#define MMA(ai,bj,At_,Bt_) do{__builtin_amdgcn_s_setprio(1); \
    _Pragma("unroll") for(int m=0;m<MI;++m) _Pragma("unroll") for(int n=0;n<2;++n) _Pragma("unroll") for(int k=0;k<2;++k) \
      acc[ai][bj][m][n]=__builtin_amdgcn_mfma_f32_16x16x32_bf16(At_[m][k],Bt_[n][k],acc[ai][bj][m][n],0,0,0); \
    __builtin_amdgcn_s_setprio(0);}while(0)
#define WAIT_V(n) asm volatile("s_waitcnt vmcnt(" #n ")":::"memory")
#define WAIT_L(n) asm volatile("s_waitcnt lgkmcnt(" #n ")":::"memory")
#define BAR __builtin_amdgcn_s_barrier()
#define SCHED __builtin_amdgcn_sched_barrier(0)
  bf16x8 At[4][2], B0[2][2], B1[2][2];
  const int nt = K / BK;
  STAGE(SB(0,0),Bt,bcol,0); STAGE(SA(0,0),A,brow,0);
  STAGE(SB(0,1),Bt,bcol+HALF,0); STAGE(SA(0,1),A,brow+AH,0);
  if(wr==1)BAR;
  WAIT_V(4); BAR;
  STAGE(SB(1,0),Bt,bcol,1); STAGE(SA(1,0),A,brow,1); STAGE(SB(1,1),Bt,bcol+HALF,1);
  WAIT_V(6); BAR;
  for(int t=0;t<nt-2;t+=2){
    LDB(B0,0,0); SCHED; LDA(At,0,0); STAGE(SA(1,1),A,brow+AH,t+1);
    WAIT_L(8); BAR; WAIT_L(0); MMA(0,0,At,B0); BAR; SCHED;
    LDB(B1,0,1); STAGE(SB(0,0),Bt,bcol,t+2);
    BAR; WAIT_L(0); MMA(0,1,At,B1); BAR;
    LDA(At,0,1); STAGE(SA(0,0),A,brow,t+2);
    BAR; WAIT_L(0); MMA(1,0,At,B0); BAR; SCHED;
    STAGE(SB(0,1),Bt,bcol+HALF,t+2);
    WAIT_V(6); BAR; MMA(1,1,At,B1); BAR;
    LDB(B0,1,0); SCHED; LDA(At,1,0); STAGE(SA(0,1),A,brow+AH,t+2);
    WAIT_L(8); BAR; WAIT_L(0); MMA(0,0,At,B0); BAR; SCHED;
    LDB(B1,1,1); STAGE(SB(1,0),Bt,bcol,t+3);
    BAR; WAIT_L(0); MMA(0,1,At,B1); BAR;
    LDA(At,1,1); STAGE(SA(1,0),A,brow,t+3);
    BAR; WAIT_L(0); MMA(1,0,At,B0); BAR; SCHED;
    STAGE(SB(1,1),Bt,bcol+HALF,t+3);
    WAIT_V(6); BAR; MMA(1,1,At,B1); BAR;
  }
  { LDB(B0,0,0); LDA(At,0,0); STAGE(SA(1,1),A,brow+AH,nt-1);
    BAR; WAIT_L(0); MMA(0,0,At,B0); BAR;
    LDB(B1,0,1); BAR; WAIT_L(0); MMA(0,1,At,B1); BAR;
    LDA(At,0,1); WAIT_V(4); BAR; WAIT_L(0); MMA(1,0,At,B0); MMA(1,1,At,B1); BAR; }
  { LDB(B0,1,0); LDA(At,1,0); WAIT_V(2); BAR; WAIT_L(0); MMA(0,0,At,B0); BAR;
    LDB(B1,1,1); WAIT_V(0); BAR; WAIT_L(0); MMA(0,1,At,B1); BAR;
    LDA(At,1,1); BAR; WAIT_L(0); MMA(1,0,At,B0); MMA(1,1,At,B1); BAR; }
  if(wr==0)BAR;
#undef SA
#undef SB
#undef STAGE
#undef LDA
#undef LDB
#undef MMA
#undef WAIT_V
#undef WAIT_L
#undef BAR
#undef SCHED
}
}
DEV bool g8_tile(int it, int ncol, int& rowt, int& colt) {
  const int x = blockIdx.x & 7, per = gridDim.x >> 3, k = (blockIdx.x >> 3) + it * per;
  if (k >= 6 * ncol) return false;
  rowt = x * 6 + (k % 6); colt = k / 6; return true;
}
DEV bool g8_tile192(int it, int ncol, int& rowt, int& colt) {
  const int x = blockIdx.x & 7, per = gridDim.x >> 3, k = (blockIdx.x >> 3) + it * per;
  if (k >= 8 * ncol) return false;
  rowt = x * 8 + (k & 7); colt = k >> 3; return true;
}
template <int MI = 4> DEV void g8_store_tile_bf16(const g8::Acc& acc, unsigned char* lds, bf16_t* dst, int ld, int tid, int wr, int wc, int fr, int fq) {
  __syncthreads();
#pragma unroll
  for (int ai = 0; ai < 2; ++ai)
#pragma unroll
    for (int bj = 0; bj < 2; ++bj)
#pragma unroll
      for (int m = 0; m < MI; ++m)
#pragma unroll
        for (int j = 0; j < 4; ++j) { unsigned char* rp = lds + (ai * (MI * 32) + wr * (MI * 16) + m * 16 + fq * 4 + j) * 528 + (bj * 128 + wc * 32 + fr) * 2;
          *(bf16_t*)rp = f2bf(acc[ai][bj][m][0][j]); *(bf16_t*)(rp + 32) = f2bf(acc[ai][bj][m][1][j]); }
  __syncthreads();
#pragma unroll 4
  for (int i = 0; i < MI * 4; ++i) { const int sl = tid + 512 * i, row = sl >> 5, ch = sl & 31;
    *(u32x4*)(dst + (size_t)row * ld + ch * 8) = *(const u32x4*)(lds + row * 528 + ch * 16); }
}
DEV void gemm256_inproj(const Params& p, unsigned char* lds) {
  const bf16_t* A = (const bf16_t*)(p.ws + OFF_ACT); const bf16_t* Bt = (const bf16_t*)(p.ws + OFF_WIN);
  float* xb = (float*)(lds + 139264);
  for (int it = 0;; ++it) {
    int rowt, colt; if (!g8_tile(it, 14, rowt, colt)) break;
    const int tid0 = tidx();
    const int brow0 = __builtin_amdgcn_readfirstlane(rowt * 256), bcol0 = __builtin_amdgcn_readfirstlane(colt * 256);
    g8::Acc acc;
#pragma unroll
    for (int ai = 0; ai < 2; ++ai)
#pragma unroll
      for (int bj = 0; bj < 2; ++bj)
#pragma unroll
        for (int m = 0; m < 4; ++m)
#pragma unroll
          for (int n = 0; n < 2; ++n) acc[ai][bj][m][n] = (f32x4){0.f, 0.f, 0.f, 0.f};
    __syncthreads();
    g8::kloop(A, Bt, 1024, brow0, bcol0, (bf16_t*)lds, acc, tid0);
    int brow = brow0, bcol = bcol0, tid = tid0; asm volatile("" : "+s"(brow), "+s"(bcol), "+v"(tid));
    const int wid = __builtin_amdgcn_readfirstlane(tid >> 6), lane = tid & 63, wr = wid >> 2, wc = wid & 3, fr = lane & 15, fq = lane >> 4;
    const int region = bcol >> 9;
#define STAGE_ROW(ai, bj, m, j, y0, y1) do { unsigned char* rp_ = lds + ((ai) * 128 + wr * 64 + (m) * 16 + fq * 4 + (j)) * 528 + ((bj) * 128 + wc * 32 + fr) * 2; \
      *(bf16_t*)rp_ = f2bf(y0); *(bf16_t*)(rp_ + 32) = f2bf(y1); } while (0)
    if (region == 4 || region == 5) {
#pragma unroll
      for (int ai = 0; ai < 2; ++ai)
#pragma unroll
        for (int bj = 0; bj < 2; ++bj)
#pragma unroll
          for (int m = 0; m < 4; ++m) { const int c = ai * 8 + bj * 4 + m; f32x4 s4;
#pragma unroll
            for (int j = 0; j < 4; ++j) { const float a0 = acc[ai][bj][m][0][j], a1 = acc[ai][bj][m][1][j]; s4[j] = row16_sum(a0 * a0 + a1 * a1); }
            if (fr == (c & 15)) *(f32x4*)(xb + ((wid * 16 + c) * 4 + fq) * 4) = s4; }
      __syncthreads();
      const float* gp = region == 4 ? p.qn_g : p.kn_g;
#pragma unroll
      for (int ai = 0; ai < 2; ++ai)
#pragma unroll
        for (int bj = 0; bj < 2; ++bj) {
          const int nb = bcol + bj * 128 + wc * 32, h = (nb >> 6) & 7, hf = (nb >> 5) & 1;
          const float g0 = gp[hf * 32 + fr] * (region == 4 ? 0.125f : 1.f), g1 = gp[hf * 32 + 16 + fr] * (region == 4 ? 0.125f : 1.f);
#pragma unroll
          for (int m = 0; m < 4; ++m) { const int c = ai * 8 + bj * 4 + m; const f32x4 po = *(const f32x4*)(xb + (((wid ^ 1) * 16 + c) * 4 + fq) * 4), pw = *(const f32x4*)(xb + ((wid * 16 + c) * 4 + fq) * 4);
            const int m4 = brow + ai * 128 + wr * 64 + m * 16 + fq * 4; const bool lat = m4 >= NCTX;
#pragma unroll
            for (int j = 0; j < 4; ++j) { const float rstd = rsqrtf((pw[j] + po[j]) * (1.f / 64.f) + EPSF);
              const float y0 = acc[ai][bj][m][0][j] * rstd * g0, y1 = acc[ai][bj][m][1][j] * rstd * g1;
              STAGE_ROW(ai, bj, m, j, y0, y1);
              if (region == 5 && !lat) { const size_t o = (size_t)(m4 + j) * 512 + h * 64 + hf * 32 + fr; p.out[OUT_NAK + o] = y0; p.out[OUT_NAK + o + 16] = y1; } } }
        }
    } else if (region <= 1) {
      const float sc = region == 1 ? 0.125f : 1.f;
      const float2* rt = (const float2*)(p.ws + OFF_ROPE); bf16_t* kt = (bf16_t*)(p.ws + OFF_KT);
      __syncthreads();
#pragma unroll
      for (int ai = 0; ai < 2; ++ai)
#pragma unroll
        for (int bj = 0; bj < 2; ++bj) {
          const int nb = bcol + bj * 128 + wc * 32, h = (nb >> 6) & 7, hf = (nb >> 5) & 1;
#pragma unroll
          for (int m = 0; m < 4; ++m) {
            const int m4 = brow + ai * 128 + wr * 64 + m * 16 + fq * 4; const bool lat = m4 >= NCTX;
            f32x4 v0 = acc[ai][bj][m][0], v1 = acc[ai][bj][m][1];
            if (lat) {
#pragma unroll
              for (int j = 0; j < 4; ++j) { const int t = (m4 + j - NCTX) & 1023; const float2 cs = rt[(hf ? (t & 63) : (t >> 6)) * 16 + fr];
                const float x1 = v0[j], x2 = v1[j]; v0[j] = (x1 * cs.x - x2 * cs.y) * sc; v1[j] = (x1 * cs.y + x2 * cs.x) * sc; }
            } else { v0 = v0 * sc; v1 = v1 * sc;
              if (region == 1) { const int b = m4 >> 8, t = m4 & 255;
                u32x2 o0, o1; o0.x = pk_bf16(v0[0], v0[1]); o0.y = pk_bf16(v0[2], v0[3]); o1.x = pk_bf16(v1[0], v1[1]); o1.y = pk_bf16(v1[2], v1[3]);
                *(u32x2*)(kt + ((size_t)(b * 8 + h) * 64 + hf * 32 + fr) * 256 + t) = o0; *(u32x2*)(kt + ((size_t)(b * 8 + h) * 64 + hf * 32 + 16 + fr) * 256 + t) = o1; } }
#pragma unroll
            for (int j = 0; j < 4; ++j) STAGE_ROW(ai, bj, m, j, v0[j], v1[j]);
          }
        }
    } else if (region == 3) {
      __syncthreads();
#pragma unroll
      for (int ai = 0; ai < 2; ++ai)
#pragma unroll
        for (int bj = 0; bj < 2; ++bj)
#pragma unroll
          for (int m = 0; m < 4; ++m)
#pragma unroll
            for (int j = 0; j < 4; ++j) STAGE_ROW(ai, bj, m, j, siluf(acc[ai][bj][m][0][j]), siluf(acc[ai][bj][m][1][j]));
    } else {
      bf16_t* vt = (bf16_t*)(p.ws + (region == 2 ? OFF_RVT : OFF_NVT));
#pragma unroll
      for (int ai = 0; ai < 2; ++ai)
#pragma unroll
        for (int bj = 0; bj < 2; ++bj) {
          const int nb = bcol + bj * 128 + wc * 32, h = (nb >> 6) & 7, hf = (nb >> 5) & 1;
#pragma unroll
          for (int m = 0; m < 4; ++m) {
            const int m4 = brow + ai * 128 + wr * 64 + m * 16 + fq * 4; const bool lat = m4 >= NCTX;
            const f32x4 v0 = acc[ai][bj][m][0], v1 = acc[ai][bj][m][1];
            size_t base; int T;
            if (!lat) { base = (size_t)((m4 >> 8) * 8 + h) * 64 * 256 + (m4 & 255); T = 256; }
            else { const int ml = m4 - NCTX; base = LAT_VT + (size_t)((ml >> 10) * 8 + h) * 64 * 1024 + (ml & 1023); T = 1024; }
            u32x2 o0, o1; o0.x = pk_bf16(v0[0], v0[1]); o0.y = pk_bf16(v0[2], v0[3]); o1.x = pk_bf16(v1[0], v1[1]); o1.y = pk_bf16(v1[2], v1[3]);
            *(u32x2*)(vt + base + (size_t)(hf * 32 + fr) * T) = o0; *(u32x2*)(vt + base + (size_t)(hf * 32 + 16 + fr) * T) = o1;
            if (region == 6 && !lat) {
#pragma unroll
              for (int j = 0; j < 4; ++j) { const size_t o = (size_t)(m4 + j) * 512 + h * 64 + hf * 32 + fr; p.out[OUT_NAV + o] = v0[j]; p.out[OUT_NAV + o + 16] = v1[j]; } }
          }
        }
    }
#undef STAGE_ROW
    if (region != 2 && region != 6) {
      const size_t roff = region == 0 ? OFF_RQ : (region == 1 ? OFF_RK : (region == 3 ? OFF_RG : (region == 4 ? OFF_NQ : OFF_NK)));
      bf16_t* dst = (bf16_t*)(p.ws + roff) + (size_t)brow * 512 + (bcol & 511);
      __syncthreads();
#pragma unroll 4
      for (int i = 0; i < 16; ++i) { const int sl = tid + 512 * i, row = sl >> 5, ch = sl & 31;
        *(u32x4*)(dst + (size_t)row * 512 + ch * 8) = *(const u32x4*)(lds + row * 528 + ch * 16); }
    }
  }
}
DEV void gemm256_outproj(const Params& p, unsigned char* lds) {
  const bf16_t* A = (const bf16_t*)(p.ws + OFF_ACT); const bf16_t* Bt = (const bf16_t*)(p.ws + OFF_WOUT);
  const float* mods = (const float*)(p.ws + OFF_MODS);
  for (int it = 0;; ++it) {
    int rowt, colt; if (!g8_tile192(it, 4, rowt, colt)) break;
    const int tid = tidx(), wid = __builtin_amdgcn_readfirstlane(tid >> 6), lane = tid & 63, wr = wid >> 2, wc = wid & 3, fr = lane & 15, fq = lane >> 4;
    const int brow = rowt * 192, bcol = colt * 256;
    g8::Acc acc;
#pragma unroll
    for (int ai = 0; ai < 2; ++ai)
#pragma unroll
      for (int bj = 0; bj < 2; ++bj)
#pragma unroll
        for (int m = 0; m < 3; ++m)
#pragma unroll
          for (int n = 0; n < 2; ++n) acc[ai][bj][m][n] = (f32x4){0.f, 0.f, 0.f, 0.f};
    __syncthreads();
    g8::kloop<3>(A, Bt, 1024, brow, bcol, (bf16_t*)lds, acc, tid);
#pragma unroll
    for (int ai = 0; ai < 2; ++ai)
#pragma unroll
      for (int m = 0; m < 3; ++m) { const int m4 = brow + ai * 96 + wr * 48 + m * 16 + fq * 4;
        const float* g1 = mods + mod_row(m4) * 6144 + 2048 + bcol + wc * 32 + fr;
        float xv[4][2][2];
#pragma unroll
        for (int j = 0; j < 4; ++j) { const float* xr = xrow(p, m4 + j) + bcol + wc * 32 + fr;
#pragma unroll
          for (int bj = 0; bj < 2; ++bj)
#pragma unroll
            for (int n = 0; n < 2; ++n) xv[j][bj][n] = xr[bj * 128 + n * 16]; }
#pragma unroll
        for (int bj = 0; bj < 2; ++bj)
#pragma unroll
          for (int n = 0; n < 2; ++n) { const float gv = g1[bj * 128 + n * 16];
#pragma unroll
            for (int j = 0; j < 4; ++j) p.out[(size_t)(m4 + j) * 1024 + bcol + bj * 128 + wc * 32 + n * 16 + fr] = xv[j][bj][n] + gv * acc[ai][bj][m][n][j]; } }
  }
}
DEV void gemm256_qp(const Params& p, unsigned char* lds) {
  const bf16_t* A = (const bf16_t*)(p.ws + OFF_ACT); const bf16_t* Bt = (const bf16_t*)(p.ws + OFF_WQ); bf16_t* dst = (bf16_t*)(p.ws + OFF_QP);
  for (int it = 0;; ++it) {
    int rowt, colt; if (!g8_tile192(it, 8, rowt, colt)) break;
    const int tid = tidx(), wid = __builtin_amdgcn_readfirstlane(tid >> 6), lane = tid & 63, wr = wid >> 2, wc = wid & 3, fr = lane & 15, fq = lane >> 4;
    const int brow = rowt * 192, bcol = colt * 256;
    g8::Acc acc;
#pragma unroll
    for (int ai = 0; ai < 2; ++ai)
#pragma unroll
      for (int bj = 0; bj < 2; ++bj)
#pragma unroll
        for (int m = 0; m < 3; ++m)
#pragma unroll
          for (int n = 0; n < 2; ++n) acc[ai][bj][m][n] = (f32x4){0.f, 0.f, 0.f, 0.f};
    __syncthreads();
    g8::kloop<3>(A, Bt, 1024, brow, bcol, (bf16_t*)lds, acc, tid);
    g8_store_tile_bf16<3>(acc, lds, dst + (size_t)brow * 2048 + bcol, 2048, tid, wr, wc, fr, fq);
  }
}

DEV float log2_sigmoid(float x) { return -log1pf(__expf(-x)) * LOG2E; }

DEV int kswz(int row) { return ((row >> 1) & 1) | (((row >> 3) & 3) << 1); }
template <bool LAT> DEV void ret_unit(const Params& p, int b, int h, int qt, unsigned char* lds) {
  constexpr bool lat = LAT;
  constexpr int T = LAT ? 1024 : 256, nkt = T >> 7;
  const int tid = tidx(), lane = tid & 63, w = tid >> 6, r = lane & 15, g = lane >> 4;
  const int tokbase = lat ? NCTX + b * 1024 : b * 256;
  const int t0 = qt * 256 + w * 32;
  const bf16_t* RQ = (const bf16_t*)(p.ws + OFF_RQ); const bf16_t* RK = (const bf16_t*)(p.ws + OFF_RK);
  bf16x8 qf[2][2];
#pragma unroll
  for (int qi = 0; qi < 2; ++qi) { const bf16_t* qrow = RQ + (size_t)(tokbase + t0 + qi * 16 + r) * 512 + h * 64 + g * 8; qf[qi][0] = *(const bf16x8*)qrow; qf[qi][1] = *(const bf16x8*)(qrow + 32); }
  const float l2f = log2_sigmoid(p.decay_f[h]), l2b = log2_sigmoid(p.decay_b[h]);
  f32x4 accO[2][4];
#pragma unroll
  for (int qi = 0; qi < 2; ++qi)
#pragma unroll
    for (int ni = 0; ni < 4; ++ni) accO[qi][ni] = (f32x4){0.f, 0.f, 0.f, 0.f};
  const bf16_t* kbase = RK + (size_t)tokbase * 512 + h * 64;
  const bf16_t* vtb = (const bf16_t*)(p.ws + OFF_RVT) + (lat ? LAT_VT + (size_t)(b * 8 + h) * 64 * 1024 : (size_t)(b * 8 + h) * 64 * 256);
  unsigned char* Ks = lds; unsigned char* Vs = lds + 16384;
  const int krow0 = tid >> 3, kch = tid & 7, ve0 = tid >> 4, vch = tid & 15;
  const bf16_t* kg = kbase + (size_t)krow0 * 512 + kch * 8;
  const bf16_t* vg = vtb + (size_t)ve0 * T + vch * 8;
  const int kso = krow0 * 128 + ((kch ^ kswz(krow0)) << 4), vso = ve0 * 256 + ((vch ^ (ve0 & 15)) << 4);
  u32x4 pk0 = *(const u32x4*)kg, pk1 = *(const u32x4*)(kg + (size_t)64 * 512), pv0 = *(const u32x4*)vg, pv1 = *(const u32x4*)(vg + (size_t)32 * T);
  const int kperm = 8 * (r >> 2) + (r & 3);
  const float af = ex2(l2f * (float)r), ab = ex2(l2b * (float)(15 - r));
  float cf[8], cb[8];
#pragma unroll
  for (int j = 0; j < 8; ++j) { cf[j] = ex2(l2f * (float)(7 - j)); cb[j] = ex2(l2b * (float)j); }
  for (int kt = 0; kt < nkt; ++kt) {
    __syncthreads();
    *(u32x4*)(Ks + kso) = pk0; *(u32x4*)(Ks + kso + 64 * 128) = pk1; *(u32x4*)(Vs + vso) = pv0; *(u32x4*)(Vs + vso + 32 * 256) = pv1;
    __syncthreads();
    if (kt + 1 < nkt) { const bf16_t* kn = kg + (size_t)(kt + 1) * 128 * 512; const bf16_t* vn = vg + (kt + 1) * 128;
      pk0 = *(const u32x4*)kn; pk1 = *(const u32x4*)(kn + (size_t)64 * 512); pv0 = *(const u32x4*)vn; pv1 = *(const u32x4*)(vn + (size_t)32 * T); }
#pragma unroll
    for (int k32 = 0; k32 < 4; ++k32) {
      const int ra = k32 * 32 + kperm, rb = ra + 4;
      bf16x8 a0[2], a1[2];
#pragma unroll
      for (int ks = 0; ks < 2; ++ks) { a0[ks] = *(const bf16x8*)(Ks + ra * 128 + (((ks * 4 + g) ^ kswz(ra)) << 4)); a1[ks] = *(const bf16x8*)(Ks + rb * 128 + (((ks * 4 + g) ^ kswz(rb)) << 4)); }
      bf16x8 vb[4];
#pragma unroll
      for (int ni = 0; ni < 4; ++ni) vb[ni] = *(const bf16x8*)(Vs + (ni * 16 + r) * 256 + (((k32 * 4 + g) ^ r) << 4));
      const int ks0 = kt * 128 + k32 * 32;
      const int sk0 = ks0 + g * 8;
      u32x4 pa[2];
#pragma unroll
      for (int qi = 0; qi < 2; ++qi) {
        const int tq0 = t0 + qi * 16;
        f32x4 s0 = (f32x4){0.f, 0.f, 0.f, 0.f}, s1 = s0;
#pragma unroll
        for (int ks = 0; ks < 2; ++ks) { s0 = mfma16(a0[ks], qf[qi][ks], s0); s1 = mfma16(a1[ks], qf[qi][ks], s1); }
        float pv[8];
        if (ks0 + 31 <= tq0) {
          const float B0 = ex2(l2f * (float)(tq0 - sk0 - 7)) * af;
#pragma unroll
          for (int reg = 0; reg < 4; ++reg) { pv[reg] = s0[reg] * (B0 * cf[reg]); pv[4 + reg] = s1[reg] * (B0 * cf[4 + reg]); }
        } else if (ks0 > tq0 + 15) {
          const float B0 = ex2(l2b * (float)(sk0 - tq0 - 15)) * ab;
#pragma unroll
          for (int reg = 0; reg < 4; ++reg) { pv[reg] = s0[reg] * (B0 * cb[reg]); pv[4 + reg] = s1[reg] * (B0 * cb[4 + reg]); }
        } else {
#pragma unroll
          for (int reg = 0; reg < 4; ++reg) {
            const int d0 = tq0 + r - (sk0 + reg), d1 = d0 - 4;
            const float w0 = d0 >= 0 ? ex2(l2f * (float)d0) : ex2(-l2b * (float)d0);
            const float w1 = d1 >= 0 ? ex2(l2f * (float)d1) : ex2(-l2b * (float)d1);
            pv[reg] = s0[reg] * w0; pv[4 + reg] = s1[reg] * w1; }
        }
        pa[qi].x = pk_bf16(pv[0], pv[1]); pa[qi].y = pk_bf16(pv[2], pv[3]); pa[qi].z = pk_bf16(pv[4], pv[5]); pa[qi].w = pk_bf16(pv[6], pv[7]);
      }
#pragma unroll
      for (int qi = 0; qi < 2; ++qi)
#pragma unroll
        for (int ni = 0; ni < 4; ++ni) accO[qi][ni] = mfma16(mk8(pa[qi]), vb[ni], accO[qi][ni]);
    }
  }
  if (lat) {
    const bf16_t* s0t = (const bf16_t*)(p.ws + OFF_S0T);
#pragma unroll
    for (int dir = 0; dir < 2; ++dir) {
      f32x4 a2[2][4];
#pragma unroll
      for (int qi = 0; qi < 2; ++qi)
#pragma unroll
        for (int ni = 0; ni < 4; ++ni) a2[qi][ni] = (f32x4){0.f, 0.f, 0.f, 0.f};
#pragma unroll
      for (int ks = 0; ks < 2; ++ks)
#pragma unroll
        for (int ni = 0; ni < 4; ++ni) { const bf16x8 bf = *(const bf16x8*)(s0t + ((size_t)((b * 2 + dir) * 8 + h) * 64 + ni * 16 + r) * 64 + ks * 32 + g * 8);
          a2[0][ni] = mfma16(qf[0][ks], bf, a2[0][ni]); a2[1][ni] = mfma16(qf[1][ks], bf, a2[1][ni]); }
#pragma unroll
      for (int qi = 0; qi < 2; ++qi)
#pragma unroll
        for (int reg = 0; reg < 4; ++reg) { const int tt = t0 + qi * 16 + g * 4 + reg; const float fac = dir == 0 ? ex2(l2f * (float)(tt + 1)) : ex2(l2b * (float)(T - tt));
#pragma unroll
          for (int ni = 0; ni < 4; ++ni) accO[qi][ni][reg] += fac * a2[qi][ni][reg]; }
    }
  }
  const bf16_t* RG = (const bf16_t*)(p.ws + OFF_RG); bf16_t* cat = (bf16_t*)(p.ws + OFF_ACT);
  float gn[4];
#pragma unroll
  for (int ni = 0; ni < 4; ++ni) gn[ni] = p.gn_g[h * 64 + ni * 16 + r];
#pragma unroll
  for (int qi = 0; qi < 2; ++qi)
#pragma unroll
    for (int reg = 0; reg < 4; ++reg) {
      float ss = 0.f;
#pragma unroll
      for (int ni = 0; ni < 4; ++ni) ss += accO[qi][ni][reg] * accO[qi][ni][reg];
      ss = row16_sum(ss);
      const float rstd = rsqrtf(ss * (1.f / 64.f) + EPSF);
      const size_t m = (size_t)(tokbase + t0 + qi * 16 + g * 4 + reg);
#pragma unroll
      for (int ni = 0; ni < 4; ++ni) { const int e = ni * 16 + r; const float gate = bf2f(RG[m * 512 + h * 64 + e]);
        cat[m * 1024 + h * 64 + e] = f2bf(gate * accO[qi][ni][reg] * rstd * gn[ni]); }
    }
}

DEV void state_unit(const Params& p, int b, int h) {
  const int tid = tidx(), lane = tid & 63, w = tid >> 6, r = lane & 15, g = lane >> 4;
  const int dir = w >> 2, dt = w & 3;
  const float l2 = dir == 0 ? log2_sigmoid(p.decay_f[h]) : log2_sigmoid(p.decay_b[h]);
  const bf16_t* kt = (const bf16_t*)(p.ws + OFF_KT) + (size_t)(b * 8 + h) * 64 * 256;
  const bf16_t* vt = (const bf16_t*)(p.ws + OFF_RVT) + (size_t)(b * 8 + h) * 64 * 256;
  f32x4 acc[4];
#pragma unroll
  for (int ni = 0; ni < 4; ++ni) acc[ni] = (f32x4){0.f, 0.f, 0.f, 0.f};
  for (int s32 = 0; s32 < 8; ++s32) {
    const u32x4 raw = *(const u32x4*)(kt + (size_t)(dt * 16 + r) * 256 + s32 * 32 + g * 8);
    const int sb = s32 * 32 + g * 8;
    float wv[8];
#pragma unroll
    for (int j = 0; j < 8; ++j) wv[j] = dir == 0 ? ex2(l2 * (float)(255 - sb - j)) : ex2(l2 * (float)(sb + j));
    u32x4 a; a.x = pk_bf16(bf_lo(raw.x) * wv[0], bf_hi(raw.x) * wv[1]); a.y = pk_bf16(bf_lo(raw.y) * wv[2], bf_hi(raw.y) * wv[3]);
    a.z = pk_bf16(bf_lo(raw.z) * wv[4], bf_hi(raw.z) * wv[5]); a.w = pk_bf16(bf_lo(raw.w) * wv[6], bf_hi(raw.w) * wv[7]);
#pragma unroll
    for (int ni = 0; ni < 4; ++ni) { const bf16x8 bfr = *(const bf16x8*)(vt + (size_t)(ni * 16 + r) * 256 + s32 * 32 + g * 8); acc[ni] = mfma16(mk8(a), bfr, acc[ni]); }
  }
  float* o = p.out + OUT_ST + (size_t)((b * 2 + dir) * 8 + h) * 4096;
#pragma unroll
  for (int ni = 0; ni < 4; ++ni)
#pragma unroll
    for (int reg = 0; reg < 4; ++reg) o[(dt * 16 + g * 4 + reg) * 64 + ni * 16 + r] = acc[ni][reg];
}

template <bool LAT> DEV void attn_wave(const Params& p, int b, int h, int qtok  , int rq, int c0, const float* rpb_l, int lane, const unsigned char* kl, const unsigned char* vl,
                                      const unsigned char* kw = nullptr  , int rb = 0  ) {
  constexpr int NCH = LAT ? 2 : 1;
  const int r = lane & 15, g = lane >> 4;
  const bf16_t* NQ = (const bf16_t*)(p.ws + OFF_NQ); const bf16_t* NK = (const bf16_t*)(p.ws + OFF_NK);
  const bf16_t* CK = (const bf16_t*)(p.ws + OFF_CK);
  const bf16_t* NVT = (const bf16_t*)(p.ws + OFF_NVT); const bf16_t* CVT = (const bf16_t*)(p.ws + OFF_CVT);
  const bf16_t* qrow = NQ + (size_t)(qtok + r) * 512 + h * 64 + g * 8;
  bf16x8 qf[2]; qf[0] = *(const bf16x8*)qrow; qf[1] = *(const bf16x8*)(qrow + 32);
  const int rs = LAT ? min(max(rq - 4, 0), 8) : 0;
  const int cs = LAT ? (c0 == 0 ? 0 : (c0 == 48 ? 32 : c0 - 8)) : 0;
  const int latbase = NCTX + b * 1024;
  const int krow_in_step = 8 * (r >> 2) + (r & 3);
  f32x4 accO[4];
#pragma unroll
  for (int ni = 0; ni < 4; ++ni) accO[ni] = (f32x4){0.f, 0.f, 0.f, 0.f};
  float m_run = -3e38f, l_run = 0.f;
#pragma unroll
  for (int ch = 0; ch < NCH; ++ch) {
    const bool win = LAT && ch == 0;
    const bf16_t* kb; size_t kstep;
    if (win) { kb = NK + (size_t)(latbase + rs * 64 + cs + krow_in_step) * 512 + h * 64 + g * 8; kstep = (size_t)64 * 512; }
    else if (LAT) { kb = CK + ((size_t)(b * 256 + krow_in_step) * 8 + h) * 64 + g * 8; kstep = (size_t)32 * 512; }
    else { kb = NK + (size_t)(b * 256 + krow_in_step) * 512 + h * 64 + g * 8; kstep = (size_t)32 * 512; }
    const size_t kodd = win ? (size_t)4 * 512 : (size_t)4 * 512;
    f32x4 s[16];
    {
      bf16x8 ka[2][4][2];
      const bool from_lds = !win;
#define LOADK(dst, j) do { if (from_lds) { const int krw = ((j) >> 1) * 32 + krow_in_step + ((j) & 1) * 4; \
          (dst)[0] = *(const bf16x8*)(kl + krw * 128 + ((g ^ (krw & 7)) << 4)); (dst)[1] = *(const bf16x8*)(kl + krw * 128 + (((4 + g) ^ (krw & 7)) << 4)); } \
        else if (LAT) { const int krw = (rs - rb + ((j) >> 1)) * 64 + cs + krow_in_step + ((j) & 1) * 4; const int sw = kswz(krw); \
          (dst)[0] = *(const bf16x8*)(kw + krw * 128 + ((g ^ sw) << 4)); (dst)[1] = *(const bf16x8*)(kw + krw * 128 + (((4 + g) ^ sw) << 4)); } \
        else { const bf16_t* kp = kb + (size_t)((j) >> 1) * kstep + ((j) & 1) * kodd; (dst)[0] = *(const bf16x8*)kp; (dst)[1] = *(const bf16x8*)(kp + 32); } } while (0)
#pragma unroll
      for (int jj = 0; jj < 4; ++jj) LOADK(ka[0][jj], jj);
#pragma unroll
      for (int hb = 0; hb < 4; ++hb) {
        if (hb < 3) {
#pragma unroll
          for (int jj = 0; jj < 4; ++jj) LOADK(ka[(hb + 1) & 1][jj], (hb + 1) * 4 + jj);
        }
        __builtin_amdgcn_sched_barrier(0);
#pragma unroll
        for (int jj = 0; jj < 4; ++jj) { f32x4 t = (f32x4){0.f, 0.f, 0.f, 0.f}; t = mfma16(ka[hb & 1][jj][0], qf[0], t); t = mfma16(ka[hb & 1][jj][1], qf[1], t); s[hb * 4 + jj] = t; }
        __builtin_amdgcn_sched_barrier(0);
      }
    }
    const bf16_t* vb; size_t vstep, vd;
    if (win) { vb = NVT + LAT_VT + ((size_t)(b * 8 + h) * 64 + r) * 1024 + rs * 64 + cs + g * 8; vstep = 64; vd = (size_t)16 * 1024; }
    else if (LAT) { vb = CVT + ((size_t)(b * 8 + h) * 64 + r) * 256 + g * 8; vstep = 32; vd = (size_t)16 * 256; }
    else { vb = NVT + ((size_t)(b * 8 + h) * 64 + r) * 256 + g * 8; vstep = 32; vd = (size_t)16 * 256; }
    bf16x8 va[4][4];
    const bool vfrom_lds = !win;
#define LOADV(kk, ni) (vfrom_lds ? *(const bf16x8*)(vl + ((ni) * 16 + r) * 528 + ((kk) * 32 + g * 8) * 2) : *(const bf16x8*)(vb + (size_t)(kk) * vstep + (ni) * vd))
#pragma unroll
    for (int kk = 0; kk < 4; ++kk)
#pragma unroll
      for (int ni = 0; ni < 4; ++ni) va[kk][ni] = LOADV(kk, ni);
    if (win) {
      const int qc = c0 + r, cst = min(max(qc - 8, 0), 48);
#pragma unroll
      for (int j = 0; j < 16; ++j) { const int dr = rs + (j >> 1) - rq + 7;
#pragma unroll
        for (int reg = 0; reg < 4; ++reg) { const int kc = cs + 8 * g + reg + 4 * (j & 1); const bool inw = (kc >= cst) && (kc < cst + 16);
          const int dc = min(max(kc - qc + 15, 0), 30);
          s[j][reg] = inw ? s[j][reg] + rpb_l[dr * 31 + dc] : -1e30f; } }
    }
    float mc = -3e38f;
#pragma unroll
    for (int j = 0; j < 16; ++j)
#pragma unroll
      for (int reg = 0; reg < 4; ++reg) mc = fmaxf(mc, s[j][reg]);
    mc = fmaxf(mc, __shfl_xor(mc, 16)); mc = fmaxf(mc, __shfl_xor(mc, 32));
    const float m_new = fmaxf(m_run, mc);
    const float alpha = ex2((m_run - m_new) * LOG2E);
    float sum = 0.f;
#pragma unroll
    for (int j = 0; j < 16; ++j)
#pragma unroll
      for (int reg = 0; reg < 4; ++reg) { const float ev = ex2((s[j][reg] - m_new) * LOG2E); s[j][reg] = ev; sum += ev; }
    sum += __shfl_xor(sum, 16); sum += __shfl_xor(sum, 32);
    l_run = l_run * alpha + sum; m_run = m_new;
    if (ch > 0) {
#pragma unroll
      for (int reg = 0; reg < 4; ++reg) { const float ar = __shfl(alpha, g * 4 + reg);
#pragma unroll
        for (int ni = 0; ni < 4; ++ni) accO[ni][reg] *= ar; }
    }
#pragma unroll
    for (int hb = 0; hb < 2; ++hb) {
      if (hb == 1) {
#pragma unroll
        for (int kk = 0; kk < 4; ++kk)
#pragma unroll
          for (int ni = 0; ni < 4; ++ni) va[kk][ni] = LOADV(4 + kk, ni);
      }
#pragma unroll
      for (int k4 = 0; k4 < 4; ++k4) { const int kk = hb * 4 + k4;
        u32x4 pa; pa.x = pk_bf16(s[2 * kk][0], s[2 * kk][1]); pa.y = pk_bf16(s[2 * kk][2], s[2 * kk][3]);
        pa.z = pk_bf16(s[2 * kk + 1][0], s[2 * kk + 1][1]); pa.w = pk_bf16(s[2 * kk + 1][2], s[2 * kk + 1][3]);
#pragma unroll
        for (int ni = 0; ni < 4; ++ni) accO[ni] = mfma16(mk8(pa), va[k4][ni], accO[ni]); }
    }
  }
  const float inv = 1.f / l_run;
  bf16_t* cat = (bf16_t*)(p.ws + OFF_ACT);
#pragma unroll
  for (int reg = 0; reg < 4; ++reg) { const size_t m = (size_t)(qtok + g * 4 + reg); const float ir = __shfl(inv, g * 4 + reg);
#pragma unroll
    for (int ni = 0; ni < 4; ++ni) cat[m * 1024 + 512 + h * 64 + ni * 16 + r] = f2bf(accO[ni][reg] * ir); }
}

DEV void stage_kv256(const bf16_t* ksrc, const bf16_t* vsrc, unsigned char* kl, unsigned char* vl, int tid) {
  u32x4 kr[4], vr[4];
#pragma unroll
  for (int i = 0; i < 4; ++i) { const int sl = tid + 512 * i; kr[i] = *(const u32x4*)(ksrc + (size_t)(sl >> 3) * 512 + (sl & 7) * 8); vr[i] = *(const u32x4*)(vsrc + (size_t)(sl >> 5) * 256 + (sl & 31) * 8); }
#pragma unroll
  for (int i = 0; i < 4; ++i) { const int sl = tid + 512 * i; const int row = sl >> 3, ch = sl & 7;
    *(u32x4*)(kl + row * 128 + ((ch ^ (row & 7)) << 4)) = kr[i];
    *(u32x4*)(vl + (sl >> 5) * 528 + (sl & 31) * 16) = vr[i]; }
}
DEV void phase3(const Params& p, unsigned char* lds) {
  for (int u = blockIdx.x; u < 1280; u += gridDim.x) {
    const int tid = tidx(), lane = tid & 63, w = tid >> 6;
    if (u < 256) ret_unit<true>(p, u >> 5, (u >> 2) & 7, u & 3, lds);
    else if (u < 768) { const int u2 = u - 256, b = u2 >> 6, h = (u2 >> 3) & 7, rp = u2 & 7;
      float* rl = (float*)lds; unsigned char* kl = lds + 2048; unsigned char* vl = kl + 32768; unsigned char* kw = lds + 68608;
      const int rb = min(max(2 * rp - 4, 0), 7);
      __syncthreads();
      { const bf16_t* ksrc = (const bf16_t*)(p.ws + OFF_NK) + (size_t)(NCTX + b * 1024 + rb * 64) * 512 + h * 64;
        u32x4 kr[9];
#pragma unroll
        for (int i = 0; i < 9; ++i) { const int sl = tid + 512 * i; kr[i] = *(const u32x4*)(ksrc + (size_t)(sl >> 3) * 512 + (sl & 7) * 8); }
        for (int i = tid; i < 465; i += 512) rl[i] = p.rpb[h * 465 + i];
        stage_kv256((const bf16_t*)(p.ws + OFF_CK) + (size_t)b * 256 * 512 + h * 64, (const bf16_t*)(p.ws + OFF_CVT) + (size_t)(b * 8 + h) * 64 * 256, kl, vl, tid);
#pragma unroll
        for (int i = 0; i < 9; ++i) { const int sl = tid + 512 * i; const int key = sl >> 3, ch = sl & 7; *(u32x4*)(kw + key * 128 + ((ch ^ kswz(key)) << 4)) = kr[i]; } }
      __syncthreads();
      const int rq = 2 * rp + (w >> 2), c0 = (w & 3) * 16;
      attn_wave<true>(p, b, h, NCTX + b * 1024 + rq * 64 + c0, rq, c0, rl, lane, kl, vl, kw, rb); }
    else if (u < 896) { const int u2 = u - 768; ret_unit<false>(p, u2 >> 3, u2 & 7, 0, lds); }
    else if (u < 1152) { const int u2 = u - 896, b = u2 >> 4, h = (u2 >> 1) & 7, qt = u2 & 1;
      unsigned char* kl = lds + 2048; unsigned char* vl = kl + 32768;
      __syncthreads();
      stage_kv256((const bf16_t*)(p.ws + OFF_NK) + (size_t)b * 256 * 512 + h * 64, (const bf16_t*)(p.ws + OFF_NVT) + (size_t)(b * 8 + h) * 64 * 256, kl, vl, tid);
      __syncthreads();
      attn_wave<false>(p, b, h, b * 256 + qt * 128 + w * 16, 0, 0, nullptr, lane, kl, vl); }
    else { const int u2 = u - 1152; state_unit(p, u2 >> 3, u2 & 7); }
  }
}

struct PairTab { int a[64]; int b[64]; };
constexpr PairTab make_pairs() { PairTab t{}; int n = 0; for (int a = 0; a < 16; ++a) for (int b = 0; b < 16; ++b) if ((a + 1) * (b + 1) <= 16) { t.a[n] = a; t.b[n] = b; ++n; }
  for (; n < 64; ++n) { t.a[n] = -1; t.b[n] = -1; } return t; }
template <int GRP> DEV void build_q(const float (&t1)[16], const float (&t2)[16], float (&q)[16]) {
  constexpr PairTab PT = make_pairs();
#pragma unroll
  for (int i = 0; i < 16; ++i) {
    constexpr int dummy = 0; (void)dummy;
    const int a = PT.a[GRP * 16 + i], bb = PT.b[GRP * 16 + i];
    if (a >= 0) { const float sum = __uint_as_float(__float_as_uint(t1[a]) & ~0x7Fu) + __uint_as_float(__float_as_uint(t2[bb]) & ~0x7Fu);
      q[i] = __uint_as_float((__float_as_uint(sum) & ~0xFFu) | (unsigned)(a * 16 + bb)); }
    else q[i] = -3.0e38f;
  }
}
DEV void peer_select_wave(const Params& p, int tg, int hd, int tid, int lane, int* ldsw, unsigned char* klds) {
  const int r = lane & 15, g = lane >> 4; const int m = tg * 16 + r;
  const bf16_t* QP = (const bf16_t*)(p.ws + OFF_QP); const bf16_t* KEYS = (const bf16_t*)(p.ws + OFF_KEYS);
  float t1[16], t2[16];
  bf16x8 bqa[2][4];
#pragma unroll
  for (int half = 0; half < 2; ++half)
#pragma unroll
    for (int ks = 0; ks < 4; ++ks) bqa[half][ks] = *(const bf16x8*)(QP + (size_t)m * 2048 + hd * 256 + half * 128 + ks * 32 + g * 8);
#pragma unroll
  for (int half = 0; half < 2; ++half) {
    const bf16x8 (&bq)[4] = bqa[half];
    const unsigned char* klh = klds + half * 32768;
    f32x4 s[8];
#pragma unroll
    for (int j = 0; j < 8; ++j) s[j] = (f32x4){0.f, 0.f, 0.f, 0.f};
#pragma unroll
    for (int ks = 0; ks < 4; ++ks)
#pragma unroll
      for (int j = 0; j < 8; ++j) { const bf16x8 ak = *(const bf16x8*)(klh + (j * 16 + r) * 256 + (((ks * 4 + g) ^ r) << 4)); s[j] = mfma16(ak, bq[ks], s[j]); }
    float v[32];
#pragma unroll
    for (int j = 0; j < 8; ++j)
#pragma unroll
      for (int reg = 0; reg < 4; ++reg) v[j * 4 + reg] = __uint_as_float((__float_as_uint(s[j][reg]) & ~0x7Fu) | (unsigned)(j * 16 + g * 4 + reg));
    bitonic_sort_desc<32>(v);
    float t[16];
#pragma unroll
    for (int i = 0; i < 16; ++i) t[i] = v[i];
#pragma unroll
    for (int step = 16; step <= 32; step <<= 1) { float o[16];
#pragma unroll
      for (int i = 0; i < 16; ++i) o[i] = __shfl_xor(t[i], step);
      top16_merge(t, o); }
#pragma unroll
    for (int i = 0; i < 16; ++i) { if (half == 0) t1[i] = t[i]; else t2[i] = t[i]; }
  }
  if (g == 0) {
#pragma unroll
    for (int i = 0; i < 16; ++i) { ldsw[r * 32 + i] = (int)(__float_as_uint(t1[i]) & 0x7Fu); ldsw[r * 32 + 16 + i] = (int)(__float_as_uint(t2[i]) & 0x7Fu); }
  }
  float q0[16];
  build_q<0>(t1, t2, q0); bitonic_sort_desc<16>(q0);
  { float q1[16]; build_q<1>(t1, t2, q1); bitonic_sort_desc<16>(q1); top16_merge(q0, q1); }
  { float q2[16]; build_q<2>(t1, t2, q2); bitonic_sort_desc<16>(q2);
    { float q3[16]; build_q<3>(t1, t2, q3); bitonic_sort_desc<16>(q3); top16_merge(q2, q3); }
    top16_merge(q0, q2); }
  const float mx = __uint_as_float(__float_as_uint(q0[0]) & ~0xFFu);
  float ev[16], sum = 0.f;
#pragma unroll
  for (int i = 0; i < 16; ++i) { ev[i] = ex2((__uint_as_float(__float_as_uint(q0[i]) & ~0xFFu) - mx) * LOG2E); sum += ev[i]; }
  const float inv = 1.f / sum;
  asm volatile("s_waitcnt lgkmcnt(0)" ::: "memory");
  __builtin_amdgcn_wave_barrier();
  int* LE = (int*)(p.ws + OFF_LE); float* LG = (float*)(p.ws + OFF_LG);
#pragma unroll
  for (int i = 0; i < 16; ++i) if ((i >> 2) == g) { const unsigned code = __float_as_uint(q0[i]) & 0xFFu;
      const int i1 = ldsw[r * 32 + (code >> 4)], i2 = ldsw[r * 32 + 16 + (code & 15)];
      LE[(size_t)m * 128 + hd * 16 + i] = i1 * 128 + i2; LG[(size_t)m * 128 + hd * 16 + i] = ev[i] * inv; }
  asm volatile("s_waitcnt lgkmcnt(0)" ::: "memory");
  __builtin_amdgcn_wave_barrier();
}
DEV void phase7(const Params& p, unsigned char* lds) {
  const int tid = tidx(), lane = tid & 63, w = tid >> 6;
  int cur_hd = -1;
  for (int unit = blockIdx.x; unit < 768; unit += gridDim.x) {
    const int hd = unit & 7;
    if (hd != cur_hd) {
      const bf16_t* ksrc = (const bf16_t*)(p.ws + OFF_KEYS) + (size_t)hd * 2 * 128 * 128;
      u32x4 kr[8];
#pragma unroll
      for (int i = 0; i < 8; ++i) { const int sl = tid + 512 * i; kr[i] = *(const u32x4*)(ksrc + (size_t)sl * 8); }
      __syncthreads();
#pragma unroll
      for (int i = 0; i < 8; ++i) { const int sl = tid + 512 * i, row = sl >> 4, ch = sl & 15; *(u32x4*)(lds + row * 256 + ((ch ^ (row & 15)) << 4)) = kr[i]; }
      __syncthreads();
      cur_hd = hd; }
    peer_select_wave(p, (unit >> 3) * 8 + w, hd, tid, lane, (int*)(lds + 65536 + w * 2048), lds);
  }
}

DEV void unpack_fp8(const u32x4& r, f32x2 (&f)[8]) {
  f[0] = __builtin_amdgcn_cvt_pk_f32_fp8((int)r.x, false); f[1] = __builtin_amdgcn_cvt_pk_f32_fp8((int)r.x, true);
  f[2] = __builtin_amdgcn_cvt_pk_f32_fp8((int)r.y, false); f[3] = __builtin_amdgcn_cvt_pk_f32_fp8((int)r.y, true);
  f[4] = __builtin_amdgcn_cvt_pk_f32_fp8((int)r.z, false); f[5] = __builtin_amdgcn_cvt_pk_f32_fp8((int)r.z, true);
  f[6] = __builtin_amdgcn_cvt_pk_f32_fp8((int)r.w, false); f[7] = __builtin_amdgcn_cvt_pk_f32_fp8((int)r.w, true);
}
struct PeerMap { int vx, nx, tbeg, tend; };
DEV PeerMap peer_map(const Params& p, unsigned xcc, unsigned nloc, unsigned* lds_word) {
  unsigned* bar = (unsigned*)(p.ws + OFF_BAR);
  PeerMap M; M.vx = 0; M.nx = 0;
#pragma unroll
  for (unsigned j = 0; j < 16; ++j) { const unsigned c = __hip_atomic_load(&bar[256 + 64 * j], __ATOMIC_RELAXED, __HIP_MEMORY_SCOPE_AGENT); if (c > 0u) { if (j < xcc) ++M.vx; ++M.nx; } }
  __syncthreads();
  if (threadIdx.x == 0) *lds_word = __hip_atomic_fetch_add(&bar[3456 + 64 * xcc], 1u, __ATOMIC_RELAXED, __HIP_MEMORY_SCOPE_AGENT);
  __syncthreads();
  const unsigned rank = (unsigned)__builtin_amdgcn_readfirstlane((int)(*lds_word % nloc));
  M.tbeg = (int)((long)rank * NTOK / nloc); M.tend = (int)((long)(rank + 1) * NTOK / nloc);
  M.vx = __builtin_amdgcn_readfirstlane(M.vx); M.nx = __builtin_amdgcn_readfirstlane(M.nx); M.tbeg = __builtin_amdgcn_readfirstlane(M.tbeg); M.tend = __builtin_amdgcn_readfirstlane(M.tend);
  return M;
}
DEV void peer_ld_rows(const unsigned char* T, const int* le_lds, int p8, int c, u32x4 (&R)[16]) {
#pragma unroll
  for (int j = 0; j < 16; ++j) R[j] = *(const u32x4*)(T + (size_t)le_lds[8 * j + p8] * 128 + c * 16);
}
DEV void peer_u_token(const u32x4 (&R)[16], const u32x4& hq, _Float16* part_n, int lane) {
  float a[16];
#pragma unroll
  for (int j = 0; j < 16; ++j) { int d = __builtin_amdgcn_sdot4((int)R[j].x, (int)hq.x, 0, false); d = __builtin_amdgcn_sdot4((int)R[j].y, (int)hq.y, d, false);
    d = __builtin_amdgcn_sdot4((int)R[j].z, (int)hq.z, d, false); d = __builtin_amdgcn_sdot4((int)R[j].w, (int)hq.w, d, false); a[j] = (float)d; }
  const bool b0 = (lane & 1) != 0, b1 = (lane & 2) != 0, b2 = (lane & 4) != 0;
  float t[8], u[4], v[2];
#pragma unroll
  for (int k = 0; k < 8; ++k) t[k] = (b0 ? a[2 * k + 1] : a[2 * k]) + __shfl_xor(b0 ? a[2 * k] : a[2 * k + 1], 1);
#pragma unroll
  for (int k = 0; k < 4; ++k) u[k] = (b1 ? t[2 * k + 1] : t[2 * k]) + __shfl_xor(b1 ? t[2 * k] : t[2 * k + 1], 2);
#pragma unroll
  for (int k = 0; k < 2; ++k) v[k] = (b2 ? u[2 * k + 1] : u[2 * k]) + __shfl_xor(b2 ? u[2 * k] : u[2 * k + 1], 4);
  const int p8 = lane >> 3, c = lane & 7;
  part_n[8 * c + p8] = (_Float16)(v[0] * 0.015625f); part_n[64 + 8 * c + p8] = (_Float16)(v[1] * 0.015625f);
}
DEV void peer_v_token(const u32x4 (&R)[16], const float* cf_lds, float* out_n, const float* g2_n, int lane) {
  const int p8 = lane >> 3, c = lane & 7;
  const int c0 = 16 * c + p8, c1 = c0 + 8;
  const float x0 = out_n[c0], x1 = out_n[c1], gg0 = g2_n[c0], gg1 = g2_n[c1];
  f32x2 acc[8];
#pragma unroll
  for (int q = 0; q < 8; ++q) acc[q] = (f32x2){0.f, 0.f};
#pragma unroll
  for (int j = 0; j < 16; ++j) { f32x2 f[8]; unpack_fp8(R[j], f); const float cj = cf_lds[8 * j + p8]; const f32x2 w = {cj, cj};
#pragma unroll
    for (int q = 0; q < 8; ++q) acc[q] = __builtin_elementwise_fma(f[q], w, acc[q]); }
  float a[16];
#pragma unroll
  for (int q = 0; q < 8; ++q) { a[2 * q] = acc[q].x; a[2 * q + 1] = acc[q].y; }
  const bool b3 = (lane & 8) != 0, b4 = (lane & 16) != 0, b5 = (lane & 32) != 0;
  float t[8], u[4], v[2];
#pragma unroll
  for (int k = 0; k < 8; ++k) t[k] = (b3 ? a[2 * k + 1] : a[2 * k]) + __shfl_xor(b3 ? a[2 * k] : a[2 * k + 1], 8);
#pragma unroll
  for (int k = 0; k < 4; ++k) u[k] = (b4 ? t[2 * k + 1] : t[2 * k]) + __shfl_xor(b4 ? t[2 * k] : t[2 * k + 1], 16);
#pragma unroll
  for (int k = 0; k < 2; ++k) v[k] = (b5 ? u[2 * k + 1] : u[2 * k]) + __shfl_xor(b5 ? u[2 * k] : u[2 * k + 1], 32);
  out_n[c0] = x0 + gg0 * v[0]; out_n[c1] = x1 + gg1 * v[1];
}
template <bool VSIDE> DEV void phase8ab(const Params& p, const PeerMap& M, int tid, unsigned char* lds) {
  const int lane = tid & 63, w = tid >> 6, p8 = lane >> 3, c = lane & 7;
  const int* LE = (const int*)(p.ws + OFF_LE); const float* CF = (const float*)(p.ws + OFF_COEF);
  int* li = (int*)(lds + w * 4096); float* lc = (float*)(lds + w * 4096 + 2048);
  const int K = (M.tend - M.tbeg - w + 7) / 8;
  for (int s = M.vx; s < 8; s += M.nx) {
    const unsigned char* T = p.ws + (VSIDE ? OFF_V : OFF_U) + (size_t)s * 16384 * 128;
    const unsigned char* H8s = p.ws + OFF_H8 + (size_t)s * 12288 * 128;
    _Float16* part = (_Float16*)(p.ws + OFF_PART) + (size_t)s * 12288 * 128;
    int pe[8]; float pc[8];
#pragma unroll
    for (int q = 0; q < 4; ++q) { const int n = M.tbeg + w + 8 * q; const bool ok = q < K; const size_t o = (size_t)(ok ? n : M.tbeg) * 128;
      pe[2 * q] = LE[o + lane]; pe[2 * q + 1] = LE[o + 64 + lane]; if (VSIDE) { pc[2 * q] = CF[o + lane]; pc[2 * q + 1] = CF[o + 64 + lane]; } }
    for (int k0 = 0; k0 < K; k0 += 4) {
      asm volatile("s_waitcnt lgkmcnt(0)" ::: "memory"); __builtin_amdgcn_wave_barrier();
#pragma unroll
      for (int q = 0; q < 4; ++q) { li[q * 128 + lane] = pe[2 * q]; li[q * 128 + 64 + lane] = pe[2 * q + 1]; if (VSIDE) { lc[q * 128 + lane] = pc[2 * q]; lc[q * 128 + 64 + lane] = pc[2 * q + 1]; } }
      asm volatile("s_waitcnt lgkmcnt(0)" ::: "memory"); __builtin_amdgcn_wave_barrier();
#pragma unroll
      for (int q = 0; q < 4; ++q) { const int kk = k0 + 4 + q; const bool ok = kk < K; const size_t o = (size_t)(ok ? M.tbeg + w + 8 * kk : M.tbeg) * 128;
        pe[2 * q] = LE[o + lane]; pe[2 * q + 1] = LE[o + 64 + lane]; if (VSIDE) { pc[2 * q] = CF[o + lane]; pc[2 * q + 1] = CF[o + 64 + lane]; } }
      const int nt = min(4, K - k0);
      const int nb = M.tbeg + w + 8 * k0;
      u32x4 RA[16], RB[16];
      peer_ld_rows(T, li, p8, c, RA);
      if (nt > 1) peer_ld_rows(T, li + 128, p8, c, RB);
      if (VSIDE) peer_v_token(RA, lc, p.out + (size_t)nb * 1024 + s * 128, (const float*)(p.ws + OFF_MODS) + mod_row(nb) * 6144 + 5 * 1024 + s * 128, lane);
      else { const u32x4 hq = *(const u32x4*)(H8s + (size_t)nb * 128 + c * 16); peer_u_token(RA, hq, part + (size_t)nb * 128, lane); }
      if (nt > 2) peer_ld_rows(T, li + 256, p8, c, RA);
      if (nt > 1) { const int n = nb + 8;
        if (VSIDE) peer_v_token(RB, lc + 128, p.out + (size_t)n * 1024 + s * 128, (const float*)(p.ws + OFF_MODS) + mod_row(n) * 6144 + 5 * 1024 + s * 128, lane);
        else { const u32x4 hq = *(const u32x4*)(H8s + (size_t)n * 128 + c * 16); peer_u_token(RB, hq, part + (size_t)n * 128, lane); } }
      if (nt > 3) peer_ld_rows(T, li + 384, p8, c, RB);
      if (nt > 2) { const int n = nb + 16;
        if (VSIDE) peer_v_token(RA, lc + 256, p.out + (size_t)n * 1024 + s * 128, (const float*)(p.ws + OFF_MODS) + mod_row(n) * 6144 + 5 * 1024 + s * 128, lane);
        else { const u32x4 hq = *(const u32x4*)(H8s + (size_t)n * 128 + c * 16); peer_u_token(RA, hq, part + (size_t)n * 128, lane); } }
      if (nt > 3) { const int n = nb + 24;
        if (VSIDE) peer_v_token(RB, lc + 384, p.out + (size_t)n * 1024 + s * 128, (const float*)(p.ws + OFF_MODS) + mod_row(n) * 6144 + 5 * 1024 + s * 128, lane);
        else { const u32x4 hq = *(const u32x4*)(H8s + (size_t)n * 128 + c * 16); peer_u_token(RB, hq, part + (size_t)n * 128, lane); } }
    }
  }
}
typedef _Float16 f16x2 __attribute__((ext_vector_type(2)));
DEV void phase8r(const Params& p) {
  const int2* LE2 = (const int2*)(p.ws + OFF_LE); const float2* LG2 = (const float2*)(p.ws + OFF_LG);
  const float* SU = (const float*)(p.ws + OFF_SU); const float* SV = (const float*)(p.ws + OFF_SV); const float* SH = (const float*)(p.ws + OFF_SH);
  const unsigned* part2 = (const unsigned*)(p.ws + OFF_PART); float2* coef2 = (float2*)(p.ws + OFF_COEF);
  const int nthr = gridDim.x * 512;
  constexpr int ND = NTOK * 64;
  for (int base = blockIdx.x * 512 + threadIdx.x; base < ND; base += 3 * nthr) {
    unsigned pr[3][8]; int2 e[3]; float2 g[3];
#pragma unroll
    for (int q = 0; q < 3; ++q) { const int idx = base + q * nthr; const int id = idx < ND ? idx : 0;
      e[q] = LE2[id]; g[q] = LG2[id];
#pragma unroll
      for (int x = 0; x < 8; ++x) pr[q][x] = part2[(size_t)x * ND + id]; }
#pragma unroll
    for (int q = 0; q < 3; ++q) { const int idx = base + q * nthr;
      if (idx < ND) { float s0 = 0.f, s1 = 0.f;
#pragma unroll
        for (int x = 0; x < 8; ++x) { const f16x2 hv = __builtin_bit_cast(f16x2, pr[q][x]); s0 += (float)hv.x; s1 += (float)hv.y; }
        const float sh = SH[idx >> 6] * 64.f;
        float2 o; o.x = g[q].x * gelu_tanh(s0 * SU[e[q].x] * sh) * SV[e[q].x]; o.y = g[q].y * gelu_tanh(s1 * SU[e[q].y] * sh) * SV[e[q].y];
        coef2[idx] = o; } }
  }
}

DEV void peer_ld_rows8(const unsigned char* T, const int* le_lds, int half, int p8, int c, u32x4 (&R)[8]) {
#pragma unroll
  for (int j = 0; j < 8; ++j) R[j] = *(const u32x4*)(T + (size_t)le_lds[8 * (half * 8 + j) + p8] * 128 + c * 16);
}
DEV void peer_v_half(const u32x4 (&R)[8], const float* cf_lds, int half, int p8, f32x2 (&acc)[8]) {
#pragma unroll
  for (int j = 0; j < 8; ++j) { const float cj = cf_lds[8 * (half * 8 + j) + p8]; const f32x2 w = {cj, cj};
    acc[0] = __builtin_elementwise_fma(__builtin_amdgcn_cvt_pk_f32_fp8((int)R[j].x, false), w, acc[0]); acc[1] = __builtin_elementwise_fma(__builtin_amdgcn_cvt_pk_f32_fp8((int)R[j].x, true), w, acc[1]);
    acc[2] = __builtin_elementwise_fma(__builtin_amdgcn_cvt_pk_f32_fp8((int)R[j].y, false), w, acc[2]); acc[3] = __builtin_elementwise_fma(__builtin_amdgcn_cvt_pk_f32_fp8((int)R[j].y, true), w, acc[3]);
    acc[4] = __builtin_elementwise_fma(__builtin_amdgcn_cvt_pk_f32_fp8((int)R[j].z, false), w, acc[4]); acc[5] = __builtin_elementwise_fma(__builtin_amdgcn_cvt_pk_f32_fp8((int)R[j].z, true), w, acc[5]);
    acc[6] = __builtin_elementwise_fma(__builtin_amdgcn_cvt_pk_f32_fp8((int)R[j].w, false), w, acc[6]); acc[7] = __builtin_elementwise_fma(__builtin_amdgcn_cvt_pk_f32_fp8((int)R[j].w, true), w, acc[7]); }
}
DEV void peer_v_finish(f32x2 (&acc)[8], f32x2 x, f32x2 gg, float* out_n, int lane) {
  const int p8 = lane >> 3, c = lane & 7;
  float a[16];
#pragma unroll
  for (int q = 0; q < 8; ++q) { a[q] = acc[q].x; a[8 + q] = acc[q].y; acc[q] = (f32x2){0.f, 0.f}; }
  const bool b3 = (lane & 8) != 0, b4 = (lane & 16) != 0, b5 = (lane & 32) != 0;
  float t[8], u[4], v[2];
#pragma unroll
  for (int k = 0; k < 8; ++k) t[k] = (b3 ? a[2 * k + 1] : a[2 * k]) + __shfl_xor(b3 ? a[2 * k] : a[2 * k + 1], 8);
#pragma unroll
  for (int k = 0; k < 4; ++k) u[k] = (b4 ? t[2 * k + 1] : t[2 * k]) + __shfl_xor(b4 ? t[2 * k] : t[2 * k + 1], 16);
#pragma unroll
  for (int k = 0; k < 2; ++k) v[k] = (b5 ? u[2 * k + 1] : u[2 * k]) + __shfl_xor(b5 ? u[2 * k] : u[2 * k + 1], 32);
  f32x2 o; o.x = x.x + gg.x * v[0]; o.y = x.y + gg.y * v[1];
  *(f32x2*)(out_n + 16 * c + 2 * p8) = o;
}
DEV void phase8v(const Params& p, const PeerMap& M, int tid, unsigned char* lds) {
  const int lane = tid & 63, w = __builtin_amdgcn_readfirstlane(tid >> 6), p8 = lane >> 3, c = lane & 7;
  const int* LE = (const int*)(p.ws + OFF_LE); const float* CF = (const float*)(p.ws + OFF_COEF);
  int* li = (int*)(lds + w * 4096); float* lc = (float*)(lds + w * 4096 + 2048);
  const int K = (M.tend - M.tbeg - w + 7) / 8;
  const int NS = 2 * K;
  const int c0 = 16 * c + 2 * p8;
  for (int s = M.vx; s < 8; s += M.nx) {
    const unsigned char* T = p.ws + OFF_V + (size_t)s * 16384 * 128;
    const float* g2base = (const float*)(p.ws + OFF_MODS) + 5 * 1024 + s * 128;
    int pe[4]; float pc[4];
    const __amdgpu_buffer_rsrc_t rs_le = __builtin_amdgcn_make_buffer_rsrc((void*)LE, 0, NTOK * 128 * 4, 0x00020000);
    const __amdgpu_buffer_rsrc_t rs_cf = __builtin_amdgcn_make_buffer_rsrc((void*)CF, 0, NTOK * 128 * 4, 0x00020000);
#define PV_FETCH_LISTS(chunk) do { _Pragma("unroll") for (int q = 0; q < 2; ++q) { const int kk = (chunk) * 2 + q; const int o = (kk < K ? M.tbeg + w + 8 * kk : M.tbeg) * 512; \
      pe[2 * q] = __builtin_amdgcn_raw_buffer_load_b32(rs_le, lane * 4, o, 0); pe[2 * q + 1] = __builtin_amdgcn_raw_buffer_load_b32(rs_le, lane * 4, o + 256, 0); \
      pc[2 * q] = __uint_as_float(__builtin_amdgcn_raw_buffer_load_b32(rs_cf, lane * 4, o, 0)); pc[2 * q + 1] = __uint_as_float(__builtin_amdgcn_raw_buffer_load_b32(rs_cf, lane * 4, o + 256, 0)); } } while (0)
#define PV_STORE_LISTS(buf) do { _Pragma("unroll") for (int q = 0; q < 2; ++q) { li[(buf) * 256 + q * 128 + lane] = pe[2 * q]; li[(buf) * 256 + q * 128 + 64 + lane] = pe[2 * q + 1]; \
      lc[(buf) * 256 + q * 128 + lane] = pc[2 * q]; lc[(buf) * 256 + q * 128 + 64 + lane] = pc[2 * q + 1]; } } while (0)
    asm volatile("s_waitcnt lgkmcnt(0)" ::: "memory"); __builtin_amdgcn_wave_barrier();
    PV_FETCH_LISTS(0); PV_STORE_LISTS(0);
    PV_FETCH_LISTS(1);
    asm volatile("s_waitcnt lgkmcnt(0)" ::: "memory"); __builtin_amdgcn_wave_barrier();
    u32x4 R0[8], R1[8], R2[8], R3[8];
    f32x2 acc[8];
#pragma unroll
    for (int q = 0; q < 8; ++q) acc[q] = (f32x2){0.f, 0.f};
    peer_ld_rows8(T, li, 0, p8, c, R0); peer_ld_rows8(T, li, 1, p8, c, R1); peer_ld_rows8(T, li + 128, 0, p8, c, R2);
    f32x2 xo = {0.f, 0.f}, ggo = {0.f, 0.f};
#pragma unroll 1
    for (int ch = 0; ch * 4 < NS; ++ch) {
      const int cur = ch & 1, nxt = cur ^ 1;
      PV_STORE_LISTS(nxt);
      PV_FETCH_LISTS(ch + 2);
      asm volatile("s_waitcnt lgkmcnt(0)" ::: "memory"); __builtin_amdgcn_wave_barrier();
      const int* lic = li + cur * 256; const float* lcc = lc + cur * 256; const int* lin = li + nxt * 256;
      const int nb = M.tbeg + w + 8 * (ch * 2);
#define PV_STEP(st, RCUR, RNEXT) do { const int gs = ch * 4 + (st); \
        if (gs + 3 < NS) { if ((st) + 3 < 4) peer_ld_rows8(T, lic + (((st) + 3) >> 1) * 128, ((st) + 3) & 1, p8, c, RNEXT); else peer_ld_rows8(T, lin + (((st) + 3 - 4) >> 1) * 128, ((st) + 3) & 1, p8, c, RNEXT); } \
        if (gs < NS) { const int n = nb + 8 * ((st) >> 1); \
          if (((st) & 1) == 0) { float* on = p.out + (size_t)n * 1024 + s * 128; const float* gn = g2base + mod_row(n) * 6144; xo = *(const f32x2*)(on + c0); ggo = *(const f32x2*)(gn + c0); } \
          peer_v_half(RCUR, lcc + ((st) >> 1) * 128, (st) & 1, p8, acc); \
          if (((st) & 1) == 1) peer_v_finish(acc, xo, ggo, p.out + (size_t)n * 1024 + s * 128, lane); } } while (0)
      PV_STEP(0, R0, R3); PV_STEP(1, R1, R0); PV_STEP(2, R2, R1); PV_STEP(3, R3, R2);
#undef PV_STEP
    }
#undef PV_FETCH_LISTS
#undef PV_STORE_LISTS
  }
}

#define XB_TMO      128
#define XB_XCNT(j)  (256  + 64 * (j))
#define XB_XSUB(j)  (1280 + 64 * (j))
#define XB_XGEN(j)  (2304 + 64 * (j))
#define XB_TOP      3328
#define XB_TOPGEN   3392
#define XB_SPIN_CAP (1u << 20)
#define LAS __attribute__((address_space(3)))
DEV unsigned xb_ld(unsigned* p) { return __hip_atomic_load(p, __ATOMIC_RELAXED, __HIP_MEMORY_SCOPE_AGENT); }
DEV unsigned xb_add(unsigned* p, unsigned v) { return __hip_atomic_fetch_add(p, v, __ATOMIC_RELAXED, __HIP_MEMORY_SCOPE_AGENT); }
DEV unsigned xb_xcc_id() { return (unsigned)__builtin_amdgcn_s_getreg((3 << 11) | 20) & 0xFu; }
#define XB_SPIN(cond, bar) do { unsigned _sp = 0; while (cond) { __builtin_amdgcn_s_sleep(1); \
    if ((++_sp & 255u) == 0u) { if (xb_ld(&(bar)[XB_TMO])) break; if (_sp > XB_SPIN_CAP) { atomicAdd(&(bar)[XB_TMO], 1u); break; } } } } while (0)
struct XcdBarrier { unsigned* bar; unsigned x; volatile LAS unsigned* st; };
DEV XcdBarrier xcd_barrier_post(unsigned* bar, volatile LAS unsigned* st) {
  XcdBarrier b; b.bar = bar; b.x = xb_xcc_id(); b.st = st;
  if (threadIdx.x == 0) (void)xb_add(&bar[XB_XCNT(b.x)], 1u);
  return b;
}
DEV void xcd_barrier_complete(unsigned* bar, unsigned x, unsigned& nloc, unsigned& nx) {
  const unsigned G = gridDim.x * gridDim.y * gridDim.z;
  unsigned sum, cnt, mine, sp = 0u;
  for (;;) {
    sum = 0u; cnt = 0u; mine = 0u;
#pragma unroll
    for (unsigned j = 0; j < 16; ++j) { const unsigned c = xb_ld(&bar[XB_XCNT(j)]); sum += c; cnt += (c > 0u) ? 1u : 0u; mine = (j == x) ? c : mine; }
    if (sum == G) break;
    __builtin_amdgcn_s_sleep(1);
    if ((++sp & 255u) == 0u) { if (xb_ld(&bar[XB_TMO])) break; if (sp > XB_SPIN_CAP) { atomicAdd(&bar[XB_TMO], 1u); break; } }
  }
  nloc = mine > 0u ? mine : 1u; nx = cnt > 0u ? cnt : 1u;
}
DEV void xcd_barrier(const XcdBarrier& b) {
  asm volatile("s_waitcnt vmcnt(0)" ::: "memory");
  __syncthreads();
  if (threadIdx.x == 0) {
    unsigned* bar = b.bar;
    __builtin_amdgcn_s_waitcnt(0);
    unsigned nloc = b.st[0], nx = b.st[1];
    if (nloc == 0u) { xcd_barrier_complete(bar, b.x, nloc, nx); b.st[0] = nloc; b.st[1] = nx; }
    const unsigned old = xb_add(&bar[XB_XSUB(b.x)], 1u);
    const unsigned gen = old / nloc;
    if (old + 1u == (gen + 1u) * nloc) {
      __builtin_amdgcn_fence(__ATOMIC_RELEASE, "agent");
      asm volatile("s_waitcnt vmcnt(0)" ::: "memory");
      (void)xb_add(&bar[XB_TOP], 1u);
    }
    const unsigned target = (gen + 1u) * nx;
    XB_SPIN(xb_ld(&bar[XB_TOP]) < target, bar);
    __builtin_amdgcn_fence(__ATOMIC_ACQUIRE, "agent");
    asm volatile("s_waitcnt vmcnt(0)" ::: "memory");
  }
  __syncthreads();
}

#ifndef PROBE_PH
#define PROBE_PH -1
#endif
#define RUN_PHASE(n, call) if (LO <= (n) && (n) <= HI) { if ((n) > LO) xcd_barrier(xb); call; if ((n) == PROBE_PH) { xcd_barrier(xb); call; } }
template <int LO, int HI> __global__ void __launch_bounds__(512) mega(Params p) {
  __shared__ __attribute__((aligned(16))) unsigned char lds[147456 + 16];
  volatile LAS unsigned* xst = (volatile LAS unsigned*)(lds + 147456);
  if (threadIdx.x < 4) xst[threadIdx.x] = 0u;
  __syncthreads();
  XcdBarrier xb = xcd_barrier_post((unsigned*)(p.ws + OFF_BAR), xst);
  RUN_PHASE(0, phase0(p, lds))
  RUN_PHASE(1, phase_mod<0>(p, lds))
  RUN_PHASE(2, gemm256_inproj(p, lds))
  RUN_PHASE(3, phase3(p, lds))
  RUN_PHASE(4, gemm256_outproj(p, lds))
  RUN_PHASE(5, phase_mod<1>(p, lds))
  RUN_PHASE(6, gemm256_qp(p, lds))
  RUN_PHASE(7, phase7(p, lds))
  if (LO <= 8 && 8 <= HI) {
    if (8 > LO) xcd_barrier(xb);
    const int tid8 = tidx();
    const PeerMap M = peer_map(p, xb.x, xst[0], (unsigned*)lds);
    phase8ab<false>(p, M, tid8, lds);
    xcd_barrier(xb);
    phase8r(p);
    xcd_barrier(xb);
    phase8v(p, M, tid8, lds);
  }
}

extern "C" void kernel_launch(void* const* d_in, const int* in_sizes, int n_in, void* d_out, int out_size, void* d_ws, size_t ws_size, hipStream_t stream) {
  Params p{};
  p.x_prompt = (const float*)d_in[0]; p.x_sample = (const float*)d_in[1]; p.cache_k = (const float*)d_in[2]; p.cache_v = (const float*)d_in[3]; p.state = (const float*)d_in[4];
  p.c = (const float*)d_in[5]; p.c_ctx = (const float*)d_in[6]; p.w_ada = (const float*)d_in[7]; p.b_ada = (const float*)d_in[8]; p.norm1_g = (const float*)d_in[9]; p.norm2_g = (const float*)d_in[10];
  p.w_in = (const float*)d_in[11]; p.decay_f = (const float*)d_in[12]; p.decay_b = (const float*)d_in[13]; p.gn_g = (const float*)d_in[14]; p.qn_g = (const float*)d_in[15]; p.kn_g = (const float*)d_in[16];
  p.rpb = (const float*)d_in[17]; p.w_out = (const float*)d_in[18]; p.wq = (const float*)d_in[19]; p.keys = (const float*)d_in[20]; p.pu = (const float*)d_in[21]; p.pv = (const float*)d_in[22];
  p.out = (float*)d_out; p.ws = (unsigned char*)d_ws;
  static int grid_blocks = 0;
  if (!grid_blocks) {
    int dev = 0, cus = 0, per_cu = 0;
    (void)hipGetDevice(&dev);
    (void)hipDeviceGetAttribute(&cus, hipDeviceAttributeMultiprocessorCount, dev);
    (void)hipOccupancyMaxActiveBlocksPerMultiprocessor(&per_cu, (const void*)mega<0, 8>, 512, 0);
    if (per_cu > 1) per_cu = 1;
    grid_blocks = cus * per_cu;
  }
  (void)hipMemsetAsync(p.ws + OFF_BAR, 0, 16384, stream);
  void* args[] = {&p};
  hipError_t e = hipLaunchCooperativeKernel((const void*)mega<0, 8>, dim3(grid_blocks), dim3(512), args, 0, stream);
  if (e != hipSuccess) fprintf(stderr, "cooperative launch failed: %s (grid %d)\n", hipGetErrorString(e), grid_blocks);
}
```

```cpp
#include <hip/hip_runtime.h>
#include <hip/hip_cooperative_groups.h>
#include <cstdio>
#include <cstdint>
namespace cg = cooperative_groups;

#define DEV __device__ __forceinline__
typedef unsigned short bf16_t;
typedef short bf16x8 __attribute__((ext_vector_type(8)));
typedef float f32x4 __attribute__((ext_vector_type(4)));
typedef int i32x2 __attribute__((ext_vector_type(2)));
typedef _Float16 f16x2 __attribute__((ext_vector_type(2)));
typedef unsigned u32x4 __attribute__((ext_vector_type(4)));
typedef unsigned u32x2 __attribute__((ext_vector_type(2)));
typedef __bf16 bf16x2_t __attribute__((ext_vector_type(2)));
typedef float f32x2 __attribute__((ext_vector_type(2)));

constexpr int NTOK = 12288, NCTX = 4096;
constexpr float EPSF = 1e-6f, LOG2E = 1.4426950408889634f;

struct Params {
  const float* x_prompt; const float* x_sample; const float* cache_k; const float* cache_v; const float* state;
  const float* c; const float* c_ctx; const float* w_ada; const float* b_ada; const float* norm1_g; const float* norm2_g;
  const float* w_in; const float* decay_f; const float* decay_b; const float* gn_g; const float* qn_g; const float* kn_g;
  const float* rpb; const float* w_out; const float* wq; const float* keys; const float* pu; const float* pv;
  float* out; unsigned char* ws;
};

constexpr size_t OFF_BAR   = 0;
constexpr size_t OFF_MODP  = 32768;
constexpr size_t OFF_MODS  = OFF_MODP + 8ull * 9 * 6144 * 4;
constexpr size_t OFF_ROPE  = OFF_MODS + 9ull * 6144 * 4;
constexpr size_t OFF_WIN   = OFF_ROPE + 8192;
constexpr size_t OFF_WOUT  = OFF_WIN + 3584ull * 1024 * 2;
constexpr size_t OFF_WQ    = OFF_WOUT + 1024ull * 1024 * 2;
constexpr size_t OFF_KEYS  = OFF_WQ + 2048ull * 1024 * 2;
constexpr size_t OFF_U     = OFF_KEYS + 262144ull * 2;
constexpr size_t OFF_V     = OFF_U + 16384ull * 1024 * 2;
constexpr size_t OFF_SU    = OFF_U + 16384ull * 1024;
constexpr size_t OFF_SV    = OFF_V + 16384ull * 1024;
constexpr size_t OFF_CK    = OFF_V + 16384ull * 1024 * 2;
constexpr size_t OFF_CVT   = OFF_CK + 1048576ull * 2;
constexpr size_t OFF_S0T   = OFF_CVT + 1048576ull * 2;
constexpr size_t OFF_ACT   = OFF_S0T + 524288ull * 2;
constexpr size_t OFF_RQ    = OFF_ACT + 12288ull * 1024 * 2;
constexpr size_t OFF_RK    = OFF_RQ + 12288ull * 512 * 2;
constexpr size_t OFF_RG    = OFF_RK + 12288ull * 512 * 2;
constexpr size_t OFF_NQ    = OFF_RG + 12288ull * 512 * 2;
constexpr size_t OFF_NK    = OFF_NQ + 12288ull * 512 * 2;
constexpr size_t OFF_RVT   = OFF_NK + 12288ull * 512 * 2;
constexpr size_t OFF_NVT   = OFF_RVT + 6291456ull * 2;
constexpr size_t OFF_KT    = OFF_NVT + 6291456ull * 2;
constexpr size_t OFF_H8    = OFF_KT + 2097152ull * 2;
constexpr size_t OFF_SH    = OFF_H8 + 12288ull * 1024;
constexpr size_t OFF_COEF  = OFF_SH + 12288ull * 4;
constexpr size_t OFF_END   = OFF_COEF + 12288ull * 128 * 4;
constexpr size_t OFF_PART  = OFF_RQ;
constexpr size_t OFF_QP    = OFF_RQ;
constexpr size_t OFF_LE    = OFF_RVT;
constexpr size_t OFF_LG    = OFF_NVT;
static_assert(OFF_END < 256ull * 1024 * 1024, "workspace too large");
constexpr size_t LAT_VT = 2097152;

constexpr size_t OUT_NAK = 12582912, OUT_NAV = 14680064, OUT_ST = 16777216;

DEV unsigned pk_bf16(float lo, float hi) { bf16x2_t v; v.x = (__bf16)lo; v.y = (__bf16)hi; return __builtin_bit_cast(unsigned, v); }
DEV float bf_lo(unsigned u) { return __uint_as_float(u << 16); }
DEV float bf_hi(unsigned u) { return __uint_as_float(u & 0xffff0000u); }
DEV float bf2f(bf16_t v) { return __uint_as_float(((unsigned)v) << 16); }
DEV bf16_t f2bf(float f) { return __builtin_bit_cast(bf16_t, (__bf16)f); }
DEV float dot2(unsigned a, unsigned b, float c) { return __builtin_amdgcn_fdot2_f32_bf16(__builtin_bit_cast(bf16x2_t, a), __builtin_bit_cast(bf16x2_t, b), c, false); }
DEV f32x4 mfma16(bf16x8 a, bf16x8 b, f32x4 c) { return __builtin_amdgcn_mfma_f32_16x16x32_bf16(a, b, c, 0, 0, 0); }
DEV float ex2(float x) { return __builtin_amdgcn_exp2f(x); }
DEV float rcpf_fast(float x) { return __builtin_amdgcn_rcpf(x); }
DEV float siluf(float x) { return x * rcpf_fast(1.f + __expf(-x)); }
DEV float gelu_tanh(float x) { const float z = 0.7978845608028654f * (x + 0.044715f * x * x * x); const float t = 1.f - 2.f * rcpf_fast(__expf(2.f * z) + 1.f); return 0.5f * x * (1.f + t); }
DEV int mod_row(int m) { return m < NCTX ? 0 : 1 + ((m - NCTX) >> 10); }
DEV const float* xrow(const Params& p, int m) { return m < NCTX ? p.x_prompt + (size_t)m * 1024 : p.x_sample + (size_t)(m - NCTX) * 1024; }
template <int CTRL> DEV float dpp_get(float v) { return __int_as_float(__builtin_amdgcn_update_dpp(__float_as_int(v), __float_as_int(v), CTRL, 0xf, 0xf, false)); }
DEV float row16_sum(float v) { v += dpp_get<0xB1>(v); v += dpp_get<0x4E>(v); v += dpp_get<0x141>(v); v += dpp_get<0x140>(v); return v; }
DEV float row16_max(float v) { v = fmaxf(v, dpp_get<0xB1>(v)); v = fmaxf(v, dpp_get<0x4E>(v)); v = fmaxf(v, dpp_get<0x141>(v)); v = fmaxf(v, dpp_get<0x140>(v)); return v; }
DEV float rows_sum(float v) {
  const u32x2 a = __builtin_amdgcn_permlane16_swap(__float_as_uint(v), __float_as_uint(v), false, false); v = __uint_as_float(a.x) + __uint_as_float(a.y);
  const u32x2 b = __builtin_amdgcn_permlane32_swap(__float_as_uint(v), __float_as_uint(v), false, false); return __uint_as_float(b.x) + __uint_as_float(b.y); }
DEV float rows_max(float v) {
  const u32x2 a = __builtin_amdgcn_permlane16_swap(__float_as_uint(v), __float_as_uint(v), false, false); v = fmaxf(__uint_as_float(a.x), __uint_as_float(a.y));
  const u32x2 b = __builtin_amdgcn_permlane32_swap(__float_as_uint(v), __float_as_uint(v), false, false); return fmaxf(__uint_as_float(b.x), __uint_as_float(b.y)); }
DEV float wave_sum(float v) { return rows_sum(row16_sum(v)); }
DEV float wave_max(float v) { return rows_max(row16_max(v)); }
DEV bf16x8 mk8(u32x4 v) { return __builtin_bit_cast(bf16x8, v); }
DEV int tidx() { int t = threadIdx.x; asm volatile("" : "+v"(t)); return t; }

DEV unsigned pack_i8x4(float a, float b, float c, float d, float sc) {
  const int ia = max(-127, min(127, __float2int_rn(a * sc))), ib = max(-127, min(127, __float2int_rn(b * sc)));
  const int ic = max(-127, min(127, __float2int_rn(c * sc))), id = max(-127, min(127, __float2int_rn(d * sc)));
  return (unsigned)(ia & 255) | ((unsigned)(ib & 255) << 8) | ((unsigned)(ic & 255) << 16) | ((unsigned)(id & 255) << 24);
}
template <int N> DEV void bitonic_sort_desc(float (&v)[N]) {
#pragma unroll
  for (int k = 2; k <= N; k <<= 1)
#pragma unroll
    for (int j = k >> 1; j > 0; j >>= 1)
#pragma unroll
      for (int i = 0; i < N; ++i) { const int l = i ^ j; if (l > i) { const bool desc = ((i & k) == 0); const float a = v[i], b = v[l]; const float hi = fmaxf(a, b), lo = fminf(a, b); v[i] = desc ? hi : lo; v[l] = desc ? lo : hi; } }
}
template <int N> DEV void bitonic_merge_desc(float (&v)[N]) {
#pragma unroll
  for (int j = N >> 1; j > 0; j >>= 1)
#pragma unroll
    for (int i = 0; i < N; ++i) { const int l = i ^ j; if (l > i) { const float a = v[i], b = v[l]; v[i] = fmaxf(a, b); v[l] = fminf(a, b); } }
}
DEV void top16_merge(float (&a)[16], const float (&b)[16]) {
#pragma unroll
  for (int i = 0; i < 16; ++i) a[i] = fmaxf(a[i], b[15 - i]);
  bitonic_merge_desc<16>(a);
}

DEV void tr_tile(const float* src, int ss, bf16_t* dst, int ds, int r0, int c0, float* tile) {
  const int tid = threadIdx.x;
  __syncthreads();
#pragma unroll
  for (int i = 0; i < 8; ++i) { const int idx = tid + 512 * i, r = idx >> 6, c = idx & 63; tile[r * 65 + c] = src[(size_t)(r0 + r) * ss + c0 + c]; }
  __syncthreads();
#pragma unroll
  for (int i = 0; i < 4; ++i) { const int idx = tid + 512 * i, cc = idx >> 5, rr = (idx & 31) * 2;
    *(unsigned*)(dst + (size_t)(c0 + cc) * ds + r0 + rr) = pk_bf16(tile[rr * 65 + cc], tile[(rr + 1) * 65 + cc]); }
}
DEV void tr_block256(const float* src, int ss, bf16_t* dst, int ds, int r0, int c0, unsigned char* tile) {
  const int tid = threadIdx.x;
  float v[32];
#pragma unroll
  for (int i = 0; i < 32; ++i) { const int idx = tid + 512 * i, r = idx >> 6, c = idx & 63; v[i] = src[(size_t)(r0 + r) * ss + c0 + c]; }
  __syncthreads();
#pragma unroll
  for (int i = 0; i < 32; ++i) { const int idx = tid + 512 * i, r = idx >> 6, c = idx & 63; *(bf16_t*)(tile + c * 528 + r * 2) = f2bf(v[i]); }
  __syncthreads();
#pragma unroll
  for (int i = 0; i < 4; ++i) { const int idx = tid + 512 * i, cc = idx >> 5, ch = idx & 31;
    *(u32x4*)(dst + (size_t)(c0 + cc) * ds + r0 + ch * 8) = *(const u32x4*)(tile + cc * 528 + ch * 16); }
}
DEV void cvt_chunk(const float* src, bf16_t* dst, size_t base) {
  const size_t i = base + (size_t)threadIdx.x * 8;
  const float4 a = *(const float4*)(src + i), b = *(const float4*)(src + i + 4);
  u32x4 o; o.x = pk_bf16(a.x, a.y); o.y = pk_bf16(a.z, a.w); o.z = pk_bf16(b.x, b.y); o.w = pk_bf16(b.z, b.w);
  *(u32x4*)(dst + i) = o;
}
DEV void cvt_row_fp8(const float* src, unsigned char* dst, float* inv_scale, int row, int lane) {
  const float* s = src + (size_t)row * 1024 + lane * 16;
  float4 v[4]; float am = 0.f;
#pragma unroll
  for (int i = 0; i < 4; ++i) { v[i] = *(const float4*)(s + i * 4); am = fmaxf(am, fmaxf(fmaxf(fabsf(v[i].x), fabsf(v[i].y)), fmaxf(fabsf(v[i].z), fabsf(v[i].w)))); }
  am = wave_max(am);
  const unsigned sb = __float_as_uint(240.f / fmaxf(am, 1e-30f)) & 0x7F800000u;
  const unsigned sbc = sb > 0x5F000000u ? 0x5F000000u : sb;
  const float sc = __uint_as_float(sbc);
  u32x4 o4; unsigned w[4];
#pragma unroll
  for (int i = 0; i < 4; ++i) { int t = __builtin_amdgcn_cvt_pk_fp8_f32(v[i].x * sc, v[i].y * sc, 0, false); t = __builtin_amdgcn_cvt_pk_fp8_f32(v[i].z * sc, v[i].w * sc, t, true); w[i] = (unsigned)t; }
  o4.x = w[0]; o4.y = w[1]; o4.z = w[2]; o4.w = w[3];
  *(u32x4*)(dst + ((size_t)(lane >> 3) * 16384 + row) * 128 + (lane & 7) * 16) = o4;
  if (lane == 0) inv_scale[row] = __uint_as_float(0x7F000000u - sbc);
}
DEV void cvt_row_i8(const float* src, unsigned char* dst, float* inv_scale, int row, int lane) {
  const float* s = src + (size_t)row * 1024 + lane * 16;
  float4 v[4]; float am = 0.f;
#pragma unroll
  for (int i = 0; i < 4; ++i) { v[i] = *(const float4*)(s + i * 4); am = fmaxf(am, fmaxf(fmaxf(fabsf(v[i].x), fabsf(v[i].y)), fmaxf(fabsf(v[i].z), fabsf(v[i].w)))); }
  am = wave_max(am);
  am = fmaxf(am, 1e-30f);
  const float sc = 127.f / am;
  u32x4 o4;
  o4.x = pack_i8x4(v[0].x, v[0].y, v[0].z, v[0].w, sc); o4.y = pack_i8x4(v[1].x, v[1].y, v[1].z, v[1].w, sc);
  o4.z = pack_i8x4(v[2].x, v[2].y, v[2].z, v[2].w, sc); o4.w = pack_i8x4(v[3].x, v[3].y, v[3].z, v[3].w, sc);
  *(u32x4*)(dst + ((size_t)(lane >> 3) * 16384 + row) * 128 + (lane & 7) * 16) = o4;
  if (lane == 0) inv_scale[row] = am * (1.f / 127.f);
}
DEV void phase0(const Params& p, unsigned char* lds) {
  const int tid = threadIdx.x;
  float* fl = (float*)lds;
  constexpr int U_ADA = 96, U_WIN = 224, U_WOUT = 64, U_WQ = 128, U_CV = 256, U_ST = 128, U_ROPE = 1, U_PU = 512, U_PV = 512, U_KEYS = 64, U_CK = 256;
  constexpr int TOTAL = U_ADA + U_WIN + U_WOUT + U_WQ + U_CV + U_ST + U_ROPE + U_PU + U_PV + U_KEYS + U_CK;
  for (int unit = blockIdx.x; unit < TOTAL; unit += gridDim.x) {
    int u = unit;
    if (u < U_ADA) {
      const int ks = u / 12, cb = u % 12;
      __syncthreads();
      for (int idx = tid; idx < 9 * 128; idx += 512) { const int r = idx >> 7, k = ks * 128 + (idx & 127); const float cv = (r == 0) ? p.c_ctx[k] : p.c[(r - 1) * 1024 + k]; fl[idx] = siluf(cv); }
      __syncthreads();
      const int n = cb * 512 + tid; float acc[9];
#pragma unroll
      for (int r = 0; r < 9; ++r) acc[r] = 0.f;
      const float* wp = p.w_ada + (size_t)(ks * 128) * 6144 + n;
#pragma unroll 1
      for (int k0 = 0; k0 < 128; k0 += 16) {
        float wv[16];
#pragma unroll
        for (int i = 0; i < 16; ++i) wv[i] = wp[(size_t)(k0 + i) * 6144];
#pragma unroll
        for (int i = 0; i < 16; ++i)
#pragma unroll
          for (int r = 0; r < 9; ++r) acc[r] += fl[r * 128 + k0 + i] * wv[i]; }
      float* mp = (float*)(p.ws + OFF_MODP);
#pragma unroll
      for (int r = 0; r < 9; ++r) mp[(size_t)(ks * 9 + r) * 6144 + n] = acc[r];
      continue;
    }
    u -= U_ADA;
    if (u < U_WIN) { tr_block256(p.w_in, 3584, (bf16_t*)(p.ws + OFF_WIN), 1024, (u / 56) * 256, (u % 56) * 64, lds); continue; }
    u -= U_WIN;
    if (u < U_WOUT) { tr_block256(p.w_out, 1024, (bf16_t*)(p.ws + OFF_WOUT), 1024, (u / 16) * 256, (u % 16) * 64, lds); continue; }
    u -= U_WOUT;
    if (u < U_WQ) { tr_block256(p.wq, 2048, (bf16_t*)(p.ws + OFF_WQ), 1024, (u / 32) * 256, (u % 32) * 64, lds); continue; }
    u -= U_WQ;
    if (u < U_CV) { const int b = u >> 5, t = u & 31; tr_tile(p.cache_v + (size_t)b * 131072, 512, (bf16_t*)(p.ws + OFF_CVT) + (size_t)b * 131072, 256, (t >> 3) * 64, (t & 7) * 64, fl); continue; }
    u -= U_CV;
    if (u < U_ST) { tr_tile(p.state + (size_t)u * 4096, 64, (bf16_t*)(p.ws + OFF_S0T) + (size_t)u * 4096, 64, 0, 0, fl); continue; }
    u -= U_ST;
    if (u < U_ROPE) {
      float2* rt = (float2*)(p.ws + OFF_ROPE);
      for (int idx = tid; idx < 1024; idx += 512) { const int pos = idx >> 4, i = idx & 15; const float fr = exp2f(-(float)i * (13.287712379549449f / 16.f)); const float ang = (float)pos * fr; rt[idx] = make_float2(cosf(ang), sinf(ang)); }
      continue;
    }
    u -= U_ROPE;
    if (u < U_PU) {
#pragma unroll
      for (int i = 0; i < 4; ++i) cvt_row_i8(p.pu, p.ws + OFF_U, (float*)(p.ws + OFF_SU), u * 32 + i * 8 + (tid >> 6), tid & 63);
      continue; }
    u -= U_PU;
    if (u < U_PV) {
#pragma unroll
      for (int i = 0; i < 4; ++i) cvt_row_fp8(p.pv, p.ws + OFF_V, (float*)(p.ws + OFF_SV), u * 32 + i * 8 + (tid >> 6), tid & 63);
      continue; }
    u -= U_PV;
    if (u < U_KEYS) { cvt_chunk(p.keys, (bf16_t*)(p.ws + OFF_KEYS), (size_t)u * 4096); continue; }
    u -= U_KEYS;
    cvt_chunk(p.cache_k, (bf16_t*)(p.ws + OFF_CK), (size_t)u * 4096);
  }
}

template <int WHICH> DEV void phase_mod(const Params& p, unsigned char* lds) {
  const int tid = threadIdx.x, lane = tid & 63, w = tid >> 6;
  float* shs = (float*)lds; float* scs = shs + 1024;
  const float* mp = (const float*)(p.ws + OFF_MODP);
  float* mods = (float*)(p.ws + OFF_MODS);
  if (WHICH == 0) {
    for (int u = blockIdx.x; u < 108; u += gridDim.x) { const int r = u / 12, n = (u % 12) * 512 + tid; float s = p.b_ada[n];
#pragma unroll
      for (int ks = 0; ks < 8; ++ks) s += mp[(size_t)(ks * 9 + r) * 6144 + n];
      mods[r * 6144 + n] = s; }
  }
  const int G = gridDim.x; const bool grouped = G == 256; const int gg = __builtin_amdgcn_readfirstlane((int)(blockIdx.x & 7)), gj = __builtin_amdgcn_readfirstlane((int)(blockIdx.x >> 3));
  const int q0 = __builtin_amdgcn_readfirstlane(grouped ? gj * 3 : (int)(blockIdx.x * 768u / (unsigned)G)), q1 = __builtin_amdgcn_readfirstlane(grouped ? gj * 3 + 3 : (int)((blockIdx.x + 1u) * 768u / (unsigned)G));
#define QMAP(i) (!grouped ? (i) : (WHICH == 0 ? (((i) >> 4) * 8 + gg) * 16 + ((i) & 15) : gg * 96 + (i)))
  int cur = -1;
  const float* gptr = WHICH == 0 ? p.norm1_g : p.norm2_g;
  bf16_t* act = (bf16_t*)(p.ws + OFF_ACT);
  for (int qb = q0; qb < q1; qb += 3) {
    float4 va[3][2][4];
#pragma unroll
    for (int gi = 0; gi < 3; ++gi) { const int q = QMAP(min(qb + gi, q1 - 1));
#pragma unroll
      for (int rr = 0; rr < 2; ++rr) { const int m = q * 16 + w + rr * 8; const float* xr = WHICH == 0 ? xrow(p, m) : p.out + (size_t)m * 1024;
#pragma unroll
        for (int i = 0; i < 4; ++i) va[gi][rr][i] = *(const float4*)(xr + i * 256 + lane * 4); } }
#pragma unroll
    for (int gi = 0; gi < 3; ++gi) {
      if (qb + gi >= q1) break;
      const int q = QMAP(qb + gi);
      const int m0 = q * 16, mr = mod_row(m0);
      if (mr != cur) {
        __syncthreads();
        for (int n = tid; n < 1024; n += 512) {
          float sh, sc;
          if (WHICH == 0) { sh = p.b_ada[n]; sc = p.b_ada[1024 + n];
#pragma unroll
            for (int ks = 0; ks < 8; ++ks) { sh += mp[(size_t)(ks * 9 + mr) * 6144 + n]; sc += mp[(size_t)(ks * 9 + mr) * 6144 + 1024 + n]; } }
          else { sh = mods[mr * 6144 + 3 * 1024 + n]; sc = mods[mr * 6144 + 4 * 1024 + n]; }
          shs[n] = sh; scs[n] = 1.f + sc; }
        __syncthreads(); cur = mr;
      }
#pragma unroll
      for (int rr = 0; rr < 2; ++rr) {
        const int m = m0 + w + rr * 8;
        float4 (&v)[4] = va[gi][rr]; float ss = 0.f;
#pragma unroll
        for (int i = 0; i < 4; ++i) ss += v[i].x * v[i].x + v[i].y * v[i].y + v[i].z * v[i].z + v[i].w * v[i].w;
        ss = wave_sum(ss);
        const float rstd = rsqrtf(ss * (1.f / 1024.f) + EPSF);
#pragma unroll
        for (int i = 0; i < 4; ++i) { const int n = i * 256 + lane * 4;
          const float4 g4 = *(const float4*)(gptr + n), s4 = *(const float4*)(shs + n), c4 = *(const float4*)(scs + n);
          const float h0 = v[i].x * rstd * g4.x * c4.x + s4.x, h1 = v[i].y * rstd * g4.y * c4.y + s4.y, h2 = v[i].z * rstd * g4.z * c4.z + s4.z, h3 = v[i].w * rstd * g4.w * c4.w + s4.w;
          u32x2 o; o.x = pk_bf16(h0, h1); o.y = pk_bf16(h2, h3);
          *(u32x2*)(act + (size_t)m * 1024 + n) = o;
          if (WHICH == 1) { v[i].x = h0; v[i].y = h1; v[i].z = h2; v[i].w = h3; } }
        if (WHICH == 1) {
          float am = 0.f;
#pragma unroll
          for (int i = 0; i < 4; ++i) am = fmaxf(am, fmaxf(fmaxf(fabsf(v[i].x), fabsf(v[i].y)), fmaxf(fabsf(v[i].z), fabsf(v[i].w))));
          am = wave_max(am);
          am = fmaxf(am, 1e-30f); const float qs = 127.f / am;
          unsigned char* h8 = p.ws + OFF_H8;
#pragma unroll
          for (int i = 0; i < 4; ++i) *(unsigned*)(h8 + ((size_t)(2 * i + (lane >> 5)) * 12288 + m) * 128 + (lane & 31) * 4) = pack_i8x4(v[i].x, v[i].y, v[i].z, v[i].w, qs);
          if (lane == 0) ((float*)(p.ws + OFF_SH))[m] = am * (1.f / 127.f);
        }
      }
    }
  }
}
#undef QMAP

template <int MI> DEV void epi_inproj(const Params& p, f32x4 (&acc)[MI][4], int mb, int nb, int lane) {
  const int r = lane & 15, g = lane >> 4;
  const int region = nb >> 9, h = (nb >> 6) & 7;
  if (region <= 1) {
    const float2* rt = (const float2*)(p.ws + OFF_ROPE);
    const float sc = region == 1 ? 0.125f : 1.f;
    bf16_t* dst = (bf16_t*)(p.ws + (region == 0 ? OFF_RQ : OFF_RK));
    bf16_t* kt = (bf16_t*)(p.ws + OFF_KT);
#pragma unroll
    for (int mi = 0; mi < MI; ++mi) {
      const int m4 = mb + mi * 16 + g * 4; const bool lat = m4 >= NCTX;
      if (lat) {
#pragma unroll
        for (int reg = 0; reg < 4; ++reg) { const int t = (m4 + reg - NCTX) & 1023; const float2 cr = rt[(t >> 6) * 16 + r], cc = rt[(t & 63) * 16 + r];
          const float a1 = acc[mi][0][reg], a2 = acc[mi][1][reg]; acc[mi][0][reg] = a1 * cr.x - a2 * cr.y; acc[mi][1][reg] = a1 * cr.y + a2 * cr.x;
          const float b1 = acc[mi][2][reg], b2 = acc[mi][3][reg]; acc[mi][2][reg] = b1 * cc.x - b2 * cc.y; acc[mi][3][reg] = b1 * cc.y + b2 * cc.x; }
      }
#pragma unroll
      for (int reg = 0; reg < 4; ++reg)
#pragma unroll
        for (int ni = 0; ni < 4; ++ni) dst[(size_t)(m4 + reg) * 512 + h * 64 + ni * 16 + r] = f2bf(acc[mi][ni][reg] * sc);
      if (region == 1 && !lat) { const int b = m4 >> 8, t = m4 & 255;
#pragma unroll
        for (int ni = 0; ni < 4; ++ni) { u32x2 o; o.x = pk_bf16(acc[mi][ni][0] * sc, acc[mi][ni][1] * sc); o.y = pk_bf16(acc[mi][ni][2] * sc, acc[mi][ni][3] * sc);
          *(u32x2*)(kt + ((size_t)(b * 8 + h) * 64 + ni * 16 + r) * 256 + t) = o; } }
    }
  } else if (region == 2 || region == 6) {
    bf16_t* vt = (bf16_t*)(p.ws + (region == 2 ? OFF_RVT : OFF_NVT));
#pragma unroll
    for (int mi = 0; mi < MI; ++mi) { const int m = mb + mi * 16 + g * 4; const bool lat = m >= NCTX;
      size_t base; int T;
      if (!lat) { base = (size_t)((m >> 8) * 8 + h) * 64 * 256 + (m & 255); T = 256; }
      else { const int ml = m - NCTX; base = LAT_VT + (size_t)((ml >> 10) * 8 + h) * 64 * 1024 + (ml & 1023); T = 1024; }
#pragma unroll
      for (int ni = 0; ni < 4; ++ni) { u32x2 o; o.x = pk_bf16(acc[mi][ni][0], acc[mi][ni][1]); o.y = pk_bf16(acc[mi][ni][2], acc[mi][ni][3]);
        *(u32x2*)(vt + base + (size_t)(ni * 16 + r) * T) = o; }
      if (region == 6 && !lat) {
#pragma unroll
        for (int reg = 0; reg < 4; ++reg)
#pragma unroll
          for (int ni = 0; ni < 4; ++ni) p.out[OUT_NAV + (size_t)(m + reg) * 512 + h * 64 + ni * 16 + r] = acc[mi][ni][reg]; } }
  } else if (region == 3) {
    bf16_t* dst = (bf16_t*)(p.ws + OFF_RG);
#pragma unroll
    for (int mi = 0; mi < MI; ++mi)
#pragma unroll
      for (int reg = 0; reg < 4; ++reg) { const int m = mb + mi * 16 + g * 4 + reg;
#pragma unroll
        for (int ni = 0; ni < 4; ++ni) dst[(size_t)m * 512 + h * 64 + ni * 16 + r] = f2bf(siluf(acc[mi][ni][reg])); }
  } else {
    const float* gp = region == 4 ? p.qn_g : p.kn_g;
    float gv[4];
#pragma unroll
    for (int ni = 0; ni < 4; ++ni) gv[ni] = gp[ni * 16 + r] * (region == 4 ? 0.125f : 1.f);
    bf16_t* dst = (bf16_t*)(p.ws + (region == 4 ? OFF_NQ : OFF_NK));
#pragma unroll
    for (int mi = 0; mi < MI; ++mi)
#pragma unroll
      for (int reg = 0; reg < 4; ++reg) { const int m = mb + mi * 16 + g * 4 + reg; const bool lat = m >= NCTX;
        float ss = 0.f;
#pragma unroll
        for (int ni = 0; ni < 4; ++ni) ss += acc[mi][ni][reg] * acc[mi][ni][reg];
        ss = row16_sum(ss);
        const float rstd = rsqrtf(ss * (1.f / 64.f) + EPSF);
#pragma unroll
        for (int ni = 0; ni < 4; ++ni) { const float y = acc[mi][ni][reg] * rstd * gv[ni];
          dst[(size_t)m * 512 + h * 64 + ni * 16 + r] = f2bf(y);
          if (region == 5 && !lat) p.out[OUT_NAK + (size_t)m * 512 + h * 64 + ni * 16 + r] = y; } }
  }
}
template <int MI> DEV void epi_outproj_prefetch(const Params& p, f32x4 (&xpre)[MI][4], int mb, int nb, int lane) {
  const int r = lane & 15, g = lane >> 4;
#pragma unroll
  for (int mi = 0; mi < MI; ++mi)
#pragma unroll
    for (int reg = 0; reg < 4; ++reg) { const float* xr = xrow(p, mb + mi * 16 + g * 4 + reg) + nb + r;
#pragma unroll
      for (int ni = 0; ni < 4; ++ni) xpre[mi][ni][reg] = xr[ni * 16]; }
}
template <int MI> DEV void epi_outproj(const Params& p, f32x4 (&acc)[MI][4], const f32x4 (&xpre)[MI][4], int mb, int nb, int lane) {
  const int r = lane & 15, g = lane >> 4;
  const float* mods = (const float*)(p.ws + OFF_MODS);
#pragma unroll
  for (int mi = 0; mi < MI; ++mi) { const int m4 = mb + mi * 16 + g * 4; const float* g1 = mods + mod_row(m4) * 6144 + 2048 + nb + r;
    float gv[4];
#pragma unroll
    for (int ni = 0; ni < 4; ++ni) gv[ni] = g1[ni * 16];
#pragma unroll
    for (int reg = 0; reg < 4; ++reg)
#pragma unroll
      for (int ni = 0; ni < 4; ++ni) p.out[(size_t)(m4 + reg) * 1024 + nb + ni * 16 + r] = xpre[mi][ni][reg] + gv[ni] * acc[mi][ni][reg]; }
}
template <int MI> DEV void epi_qp(const Params& p, f32x4 (&acc)[MI][4], int mb, int nb, int lane) {
  const int r = lane & 15, g = lane >> 4;
  bf16_t* dst = (bf16_t*)(p.ws + OFF_QP);
#pragma unroll
  for (int mi = 0; mi < MI; ++mi)
#pragma unroll
    for (int reg = 0; reg < 4; ++reg) { const int m = mb + mi * 16 + g * 4 + reg;
#pragma unroll
      for (int ni = 0; ni < 4; ++ni) dst[(size_t)m * 2048 + nb + ni * 16 + r] = f2bf(acc[mi][ni][reg]); }
}

template <int MODE, int BM> DEV void gemm_phase(const Params& p, unsigned char* lds, const bf16_t* A, const bf16_t* Bt, int N) {
  constexpr int MI = BM / 64, NA = BM / 64;
  constexpr int ABYTES = BM * 128, STAGE = ABYTES + 128 * 128;
  const int tid = tidx(), lane = tid & 63, w = tid >> 6, wm = w >> 1, wn = w & 1, r = lane & 15, g = lane >> 4;
  const int tn = N >> 7, ntiles = (NTOK / BM) * tn;
  for (int tile = blockIdx.x; tile < ntiles; tile += gridDim.x) {
    const int m0 = (tile / tn) * BM, n0 = (tile % tn) * 128;
    f32x4 acc[MI][4];
#pragma unroll
    for (int mi = 0; mi < MI; ++mi)
#pragma unroll
      for (int ni = 0; ni < 4; ++ni) acc[mi][ni] = (f32x4){0.f, 0.f, 0.f, 0.f};
    f32x4 xpre[MODE == 1 ? MI : 1][4];
    if (MODE == 1) epi_outproj_prefetch<MI>(p, (f32x4 (&)[MI][4])xpre, m0 + wm * (BM / 4), n0 + wn * 64, lane);
    const int srow = tid >> 3, lch = (tid & 7) ^ (srow & 7);
    const bf16_t* ap = A + (size_t)(m0 + srow) * 1024 + lch * 8;
    const bf16_t* bp = Bt + (size_t)(n0 + srow) * 1024 + lch * 8;
    __syncthreads();
#define GEMM_ISSUE(tt) do { unsigned char* Sn = lds + ((tt) % 3) * STAGE; \
      _Pragma("unroll") for (int i = 0; i < NA; ++i) __builtin_amdgcn_global_load_lds((const unsigned*)(ap + (size_t)i * 64 * 1024 + (tt) * 64), (__attribute__((address_space(3))) unsigned*)(Sn + i * 8192 + tid * 16), 16, 0, 0); \
      _Pragma("unroll") for (int i = 0; i < 2; ++i) __builtin_amdgcn_global_load_lds((const unsigned*)(bp + (size_t)i * 64 * 1024 + (tt) * 64), (__attribute__((address_space(3))) unsigned*)(Sn + ABYTES + i * 8192 + tid * 16), 16, 0, 0); } while (0)
    GEMM_ISSUE(0); GEMM_ISSUE(1);
    for (int t = 0; t < 16; ++t) {
      if (t < 15) { if (NA == 3) asm volatile("s_waitcnt vmcnt(5)" ::: "memory"); else asm volatile("s_waitcnt vmcnt(6)" ::: "memory"); }
      else asm volatile("s_waitcnt vmcnt(0)" ::: "memory");
      __builtin_amdgcn_s_barrier();
      asm volatile("" ::: "memory");
      if (t + 2 < 16) GEMM_ISSUE(t + 2);
      unsigned char* As = lds + (t % 3) * STAGE; unsigned char* Bs = As + ABYTES;
#pragma unroll
      for (int ks = 0; ks < 2; ++ks) {
        bf16x8 a[MI], b[4];
        const int coff = ((ks * 4 + g) ^ (r & 7)) << 4;
#pragma unroll
        for (int mi = 0; mi < MI; ++mi) a[mi] = *(const bf16x8*)(As + (wm * (BM / 4) + mi * 16 + r) * 128 + coff);
#pragma unroll
        for (int ni = 0; ni < 4; ++ni) b[ni] = *(const bf16x8*)(Bs + (wn * 64 + ni * 16 + r) * 128 + coff);
#pragma unroll
        for (int mi = 0; mi < MI; ++mi)
#pragma unroll
          for (int ni = 0; ni < 4; ++ni) acc[mi][ni] = mfma16(a[mi], b[ni], acc[mi][ni]);
      }
    }
#undef GEMM_ISSUE
    asm volatile("s_waitcnt lgkmcnt(0)" ::: "memory");
    const int mb = m0 + wm * (BM / 4), nb = n0 + wn * 64;
    if (MODE == 0) epi_inproj<MI>(p, acc, mb, nb, lane);
    else if (MODE == 1) epi_outproj<MI>(p, acc, (const f32x4 (&)[MI][4])xpre, mb, nb, lane);
    else epi_qp<MI>(p, acc, mb, nb, lane);
  }
}

namespace g8 {
constexpr int BM = 256, BK = 64, HALF = 128, HT = HALF * BK;
DEV int lds_byte(int r, int c) { const int st = (r >> 4) * 2 + (c >> 5), rr = r & 15, cc = c & 31, ob = rr * 64 + cc * 2; return st * 1024 + (ob ^ (((ob >> 9) & 1) << 5)); }
DEV void stage_rc(int b, int& R, int& C) { const int st = b / 1024, sb = b % 1024, swz = sb ^ (((sb >> 9) & 1) << 5); R = (st >> 1) * 16 + swz / 64; C = (st & 1) * 32 + (swz % 64) / 2; }
typedef f32x4 Acc[2][2][4][2];
template <int MI = 4> DEV void kloop(const bf16_t* A, const bf16_t* Bt, int K, int brow, int bcol, bf16_t* shm, Acc& acc, int tid) {
  constexpr int AH = MI * 32;
  const int wid = __builtin_amdgcn_readfirstlane(tid >> 6), lane = tid & 63, wr = wid >> 2, wc = wid & 3, fr = lane & 15, fq = lane >> 4;
#define SA(b,h) (shm+((b)*2+(h))*HT)
#define SB(b,h) (shm+(4+(b)*2+(h))*HT)
#define STAGE(P,BASE,br,kt) do{ const long _g=(long)(br)*K+(long)(kt)*BK; \
    _Pragma("unroll") for(int _i=0;_i<2;++_i){ const int _b=tid*16+_i*8192; int _r,_c; stage_rc(_b,_r,_c); \
      __builtin_amdgcn_global_load_lds((const unsigned*)((BASE)+_g+(long)_r*K+_c), (__attribute__((address_space(3))) unsigned*)((unsigned char*)(P)+_b),16,0,0);}}while(0)
#define LDA(dst,b,h) _Pragma("unroll") for(int m=0;m<MI;++m) _Pragma("unroll") for(int k=0;k<2;++k) \
    dst[m][k]=*reinterpret_cast<const bf16x8*>((const unsigned char*)SA(b,h)+lds_byte(wr*(MI*16)+m*16+fr,k*32+fq*8))
#define LDB(dst,b,h) _Pragma("unroll") for(int n=0;n<2;++n) _Pragma("unroll") for(int k=0;k<2;++k) \
    dst[n][k]=*reinterpret_cast<const bf16x8*>((const unsigned char*)SB(b,h)+lds_byte(wc*32+n*16+fr,k*32+fq*8))
#define MMA(ai,bj,At_,Bt_) do{__builtin_amdgcn_s_setprio(1); \
    _Pragma("unroll") for(int m=0;m<MI;++m) _Pragma("unroll") for(int n=0;n<2;++n) _Pragma("unroll") for(int k=0;k<2;++k) \
      acc[ai][bj][m][n]=__builtin_amdgcn_mfma_f32_16x16x32_bf16(At_[m][k],Bt_[n][k],acc[ai][bj][m][n],0,0,0); \
    __builtin_amdgcn_s_setprio(0);}while(0)
#define WAIT_V(n) asm volatile("s_waitcnt vmcnt(" #n ")":::"memory")
#define WAIT_L(n) asm volatile("s_waitcnt lgkmcnt(" #n ")":::"memory")
#define BAR __builtin_amdgcn_s_barrier()
#define SCHED __builtin_amdgcn_sched_barrier(0)
  bf16x8 At[4][2], B0[2][2], B1[2][2];
  const int nt = K / BK;
  STAGE(SB(0,0),Bt,bcol,0); STAGE(SA(0,0),A,brow,0);
  STAGE(SB(0,1),Bt,bcol+HALF,0); STAGE(SA(0,1),A,brow+AH,0);
  if(wr==1)BAR;
  WAIT_V(4); BAR;
  STAGE(SB(1,0),Bt,bcol,1); STAGE(SA(1,0),A,brow,1); STAGE(SB(1,1),Bt,bcol+HALF,1);
  WAIT_V(6); BAR;
  for(int t=0;t<nt-2;t+=2){
    LDB(B0,0,0); SCHED; LDA(At,0,0); STAGE(SA(1,1),A,brow+AH,t+1);
    WAIT_L(8); BAR; WAIT_L(0); MMA(0,0,At,B0); BAR; SCHED;
    LDB(B1,0,1); STAGE(SB(0,0),Bt,bcol,t+2);
    BAR; WAIT_L(0); MMA(0,1,At,B1); BAR;
    LDA(At,0,1); STAGE(SA(0,0),A,brow,t+2);
    BAR; WAIT_L(0); MMA(1,0,At,B0); BAR; SCHED;
    STAGE(SB(0,1),Bt,bcol+HALF,t+2);
    WAIT_V(6); BAR; MMA(1,1,At,B1); BAR;
    LDB(B0,1,0); SCHED; LDA(At,1,0); STAGE(SA(0,1),A,brow+AH,t+2);
    WAIT_L(8); BAR; WAIT_L(0); MMA(0,0,At,B0); BAR; SCHED;
    LDB(B1,1,1); STAGE(SB(1,0),Bt,bcol,t+3);
    BAR; WAIT_L(0); MMA(0,1,At,B1); BAR;
    LDA(At,1,1); STAGE(SA(1,0),A,brow,t+3);
    BAR; WAIT_L(0); MMA(1,0,At,B0); BAR; SCHED;
    STAGE(SB(1,1),Bt,bcol+HALF,t+3);
    WAIT_V(6); BAR; MMA(1,1,At,B1); BAR;
  }
  { LDB(B0,0,0); LDA(At,0,0); STAGE(SA(1,1),A,brow+AH,nt-1);
    BAR; WAIT_L(0); MMA(0,0,At,B0); BAR;
    LDB(B1,0,1); BAR; WAIT_L(0); MMA(0,1,At,B1); BAR;
    LDA(At,0,1); WAIT_V(4); BAR; WAIT_L(0); MMA(1,0,At,B0); MMA(1,1,At,B1); BAR; }
  { LDB(B0,1,0); LDA(At,1,0); WAIT_V(2); BAR; WAIT_L(0); MMA(0,0,At,B0); BAR;
    LDB(B1,1,1); WAIT_V(0); BAR; WAIT_L(0); MMA(0,1,At,B1); BAR;
    LDA(At,1,1); BAR; WAIT_L(0); MMA(1,0,At,B0); MMA(1,1,At,B1); BAR; }
  if(wr==0)BAR;
#undef SA
#undef SB
#undef STAGE
#undef LDA
#undef LDB
#undef MMA
#undef WAIT_V
#undef WAIT_L
#undef BAR
#undef SCHED
}
}
DEV bool g8_tile(int it, int ncol, int& rowt, int& colt) {
  const int x = blockIdx.x & 7, per = gridDim.x >> 3, k = (blockIdx.x >> 3) + it * per;
  if (k >= 6 * ncol) return false;
  rowt = x * 6 + (k % 6); colt = k / 6; return true;
}
DEV bool g8_tile192(int it, int ncol, int& rowt, int& colt) {
  const int x = blockIdx.x & 7, per = gridDim.x >> 3, k = (blockIdx.x >> 3) + it * per;
  if (k >= 8 * ncol) return false;
  rowt = x * 8 + (k & 7); colt = k >> 3; return true;
}
DEV bool p2_tile(int it, int& rowt, int& colt) {
  const int x = blockIdx.x & 7, per = gridDim.x >> 3, j = blockIdx.x >> 3;
  if (per != 32 || (gridDim.x & 7)) { const int k = j + it * per; if (k >= 6 * 14) return false; rowt = (k % 6) * 8 + x; colt = k / 6; return true; }
  int idx, col;
  if (j < 12) {
    if (it >= 2) return false;
    idx = it == 0 ? j : 23 - j;
    const int c4 = idx / 6; col = c4 < 2 ? 10 + c4 : 6 + c4;
  } else {
    if (it >= 3) return false;
    idx = it * 20 + (j - 12);
    const int c10 = idx / 6; col = c10 < 4 ? c10 : (c10 < 6 ? c10 + 2 : (c10 < 8 ? c10 + 6 : c10 - 4));
  }
  rowt = (idx % 6) * 8 + x; colt = col; return true;
}
template <int MI = 4> DEV void g8_store_tile_bf16(const g8::Acc& acc, unsigned char* lds, bf16_t* dst, int ld, int tid, int wr, int wc, int fr, int fq) {
  __syncthreads();
#pragma unroll
  for (int ai = 0; ai < 2; ++ai)
#pragma unroll
    for (int bj = 0; bj < 2; ++bj)
#pragma unroll
      for (int m = 0; m < MI; ++m)
#pragma unroll
        for (int j = 0; j < 4; ++j) { unsigned char* rp = lds + (ai * (MI * 32) + wr * (MI * 16) + m * 16 + fq * 4 + j) * 528 + (bj * 128 + wc * 32 + fr) * 2;
          *(bf16_t*)rp = f2bf(acc[ai][bj][m][0][j]); *(bf16_t*)(rp + 32) = f2bf(acc[ai][bj][m][1][j]); }
  __syncthreads();
#pragma unroll 4
  for (int i = 0; i < MI * 4; ++i) { const int sl = tid + 512 * i, row = sl >> 5, ch = sl & 31;
    *(u32x4*)(dst + (size_t)row * ld + ch * 8) = *(const u32x4*)(lds + row * 528 + ch * 16); }
}
DEV void gemm256_inproj(const Params& p, unsigned char* lds) {
  const bf16_t* A = (const bf16_t*)(p.ws + OFF_ACT); const bf16_t* Bt = (const bf16_t*)(p.ws + OFF_WIN);
  float* xb = (float*)(lds + 139264);
  for (int it = 0;; ++it) {
    int rowt, colt; if (!p2_tile(it, rowt, colt)) break;
    const int tid0 = tidx();
    const int brow0 = __builtin_amdgcn_readfirstlane(rowt * 256), bcol0 = __builtin_amdgcn_readfirstlane(colt * 256);
    g8::Acc acc;
#pragma unroll
    for (int ai = 0; ai < 2; ++ai)
#pragma unroll
      for (int bj = 0; bj < 2; ++bj)
#pragma unroll
        for (int m = 0; m < 4; ++m)
#pragma unroll
          for (int n = 0; n < 2; ++n) acc[ai][bj][m][n] = (f32x4){0.f, 0.f, 0.f, 0.f};
    __syncthreads();
    g8::kloop(A, Bt, 1024, brow0, bcol0, (bf16_t*)lds, acc, tid0);
    int brow = brow0, bcol = bcol0, tid = tid0; asm volatile("" : "+s"(brow), "+s"(bcol), "+v"(tid));
    const int wid = __builtin_amdgcn_readfirstlane(tid >> 6), lane = tid & 63, wr = wid >> 2, wc = wid & 3, fr = lane & 15, fq = lane >> 4;
    const int region = bcol >> 9;
#define STAGE_ROW(ai, bj, m, j, y0, y1) do { unsigned char* rp_ = lds + ((ai) * 128 + wr * 64 + (m) * 16 + fq * 4 + (j)) * 528 + ((bj) * 128 + wc * 32 + fr) * 2; \
      *(bf16_t*)rp_ = f2bf(y0); *(bf16_t*)(rp_ + 32) = f2bf(y1); } while (0)
    if (region == 4 || region == 5) {
#pragma unroll
      for (int ai = 0; ai < 2; ++ai)
#pragma unroll
        for (int bj = 0; bj < 2; ++bj)
#pragma unroll
          for (int m = 0; m < 4; ++m) { const int c = ai * 8 + bj * 4 + m; f32x4 s4;
#pragma unroll
            for (int j = 0; j < 4; ++j) { const float a0 = acc[ai][bj][m][0][j], a1 = acc[ai][bj][m][1][j]; s4[j] = row16_sum(a0 * a0 + a1 * a1); }
            if (fr == (c & 15)) *(f32x4*)(xb + ((wid * 16 + c) * 4 + fq) * 4) = s4; }
      __syncthreads();
      const float* gp = region == 4 ? p.qn_g : p.kn_g;
#pragma unroll
      for (int ai = 0; ai < 2; ++ai)
#pragma unroll
        for (int bj = 0; bj < 2; ++bj) {
          const int nb = bcol + bj * 128 + wc * 32, h = (nb >> 6) & 7, hf = (nb >> 5) & 1;
          const float g0 = gp[hf * 32 + fr] * (region == 4 ? 0.125f : 1.f), g1 = gp[hf * 32 + 16 + fr] * (region == 4 ? 0.125f : 1.f);
#pragma unroll
          for (int m = 0; m < 4; ++m) { const int c = ai * 8 + bj * 4 + m; const f32x4 po = *(const f32x4*)(xb + (((wid ^ 1) * 16 + c) * 4 + fq) * 4), pw = *(const f32x4*)(xb + ((wid * 16 + c) * 4 + fq) * 4);
            const int m4 = brow + ai * 128 + wr * 64 + m * 16 + fq * 4; const bool lat = m4 >= NCTX;
#pragma unroll
            for (int j = 0; j < 4; ++j) { const float rstd = rsqrtf((pw[j] + po[j]) * (1.f / 64.f) + EPSF);
              const float y0 = acc[ai][bj][m][0][j] * rstd * g0, y1 = acc[ai][bj][m][1][j] * rstd * g1;
              STAGE_ROW(ai, bj, m, j, y0, y1);
              if (region == 5 && !lat) { const size_t o = (size_t)(m4 + j) * 512 + h * 64 + hf * 32 + fr; p.out[OUT_NAK + o] = y0; p.out[OUT_NAK + o + 16] = y1; } } }
        }
    } else if (region <= 1) {
      const float sc = region == 1 ? 0.125f : 1.f;
      const float2* rt = (const float2*)(p.ws + OFF_ROPE); bf16_t* kt = (bf16_t*)(p.ws + OFF_KT);
      __syncthreads();
#pragma unroll
      for (int ai = 0; ai < 2; ++ai)
#pragma unroll
        for (int bj = 0; bj < 2; ++bj) {
          const int nb = bcol + bj * 128 + wc * 32, h = (nb >> 6) & 7, hf = (nb >> 5) & 1;
#pragma unroll
          for (int m = 0; m < 4; ++m) {
            const int m4 = brow + ai * 128 + wr * 64 + m * 16 + fq * 4; const bool lat = m4 >= NCTX;
            f32x4 v0 = acc[ai][bj][m][0], v1 = acc[ai][bj][m][1];
            if (lat) {
#pragma unroll
              for (int j = 0; j < 4; ++j) { const int t = (m4 + j - NCTX) & 1023; const float2 cs = rt[(hf ? (t & 63) : (t >> 6)) * 16 + fr];
                const float x1 = v0[j], x2 = v1[j]; v0[j] = (x1 * cs.x - x2 * cs.y) * sc; v1[j] = (x1 * cs.y + x2 * cs.x) * sc; }
            } else { v0 = v0 * sc; v1 = v1 * sc;
              if (region == 1) { const int b = m4 >> 8, t = m4 & 255;
                u32x2 o0, o1; o0.x = pk_bf16(v0[0], v0[1]); o0.y = pk_bf16(v0[2], v0[3]); o1.x = pk_bf16(v1[0], v1[1]); o1.y = pk_bf16(v1[2], v1[3]);
                *(u32x2*)(kt + ((size_t)(b * 8 + h) * 64 + hf * 32 + fr) * 256 + t) = o0; *(u32x2*)(kt + ((size_t)(b * 8 + h) * 64 + hf * 32 + 16 + fr) * 256 + t) = o1; } }
#pragma unroll
            for (int j = 0; j < 4; ++j) STAGE_ROW(ai, bj, m, j, v0[j], v1[j]);
          }
        }
    } else if (region == 3) {
      __syncthreads();
#pragma unroll
      for (int ai = 0; ai < 2; ++ai)
#pragma unroll
        for (int bj = 0; bj < 2; ++bj)
#pragma unroll
          for (int m = 0; m < 4; ++m)
#pragma unroll
            for (int j = 0; j < 4; ++j) STAGE_ROW(ai, bj, m, j, siluf(acc[ai][bj][m][0][j]), siluf(acc[ai][bj][m][1][j]));
    } else {
      bf16_t* vt = (bf16_t*)(p.ws + (region == 2 ? OFF_RVT : OFF_NVT));
      __syncthreads();
#pragma unroll
      for (int ai = 0; ai < 2; ++ai)
#pragma unroll
        for (int bj = 0; bj < 2; ++bj) {
          const int nb = bcol + bj * 128 + wc * 32, h = (nb >> 6) & 7, hf = (nb >> 5) & 1;
#pragma unroll
          for (int m = 0; m < 4; ++m) {
            const int rl = ai * 128 + wr * 64 + m * 16 + fq * 4; const int m4 = brow + rl; const bool lat = m4 >= NCTX;
            const f32x4 v0 = acc[ai][bj][m][0], v1 = acc[ai][bj][m][1];
            u32x2 o0, o1; o0.x = pk_bf16(v0[0], v0[1]); o0.y = pk_bf16(v0[2], v0[3]); o1.x = pk_bf16(v1[0], v1[1]); o1.y = pk_bf16(v1[2], v1[3]);
            const int cl = bj * 128 + wc * 32 + fr;
            *(u32x2*)(lds + cl * 528 + rl * 2) = o0; *(u32x2*)(lds + (cl + 16) * 528 + rl * 2) = o1;
            if (region == 6 && !lat) {
#pragma unroll
              for (int j = 0; j < 4; ++j) { const size_t o = (size_t)(m4 + j) * 512 + h * 64 + hf * 32 + fr; p.out[OUT_NAV + o] = v0[j]; p.out[OUT_NAV + o + 16] = v1[j]; } }
          }
        }
      __syncthreads();
      { size_t tb; int T;
        if (brow < NCTX) { tb = (size_t)((brow >> 8) * 8) * 64 * 256 + (brow & 255); T = 256; }
        else { const int ml = brow - NCTX; tb = LAT_VT + (size_t)((ml >> 10) * 8) * 64 * 1024 + (ml & 1023); T = 1024; }
#pragma unroll 4
        for (int i = 0; i < 16; ++i) { const int sl = tid + 512 * i, cr = sl >> 5, ch = sl & 31; const int hd = (bcol & 511) + cr;
          *(u32x4*)(vt + tb + (size_t)hd * T + ch * 8) = *(const u32x4*)(lds + cr * 528 + ch * 16); } }
    }
#undef STAGE_ROW
    if (region != 2 && region != 6) {
      const size_t roff = region == 0 ? OFF_RQ : (region == 1 ? OFF_RK : (region == 3 ? OFF_RG : (region == 4 ? OFF_NQ : OFF_NK)));
      bf16_t* dst = (bf16_t*)(p.ws + roff) + (size_t)brow * 512 + (bcol & 511);
      __syncthreads();
#pragma unroll 4
      for (int i = 0; i < 16; ++i) { const int sl = tid + 512 * i, row = sl >> 5, ch = sl & 31;
        *(u32x4*)(dst + (size_t)row * 512 + ch * 8) = *(const u32x4*)(lds + row * 528 + ch * 16); }
    }
  }
}
DEV void gemm256_outproj(const Params& p, unsigned char* lds) {
  const bf16_t* A = (const bf16_t*)(p.ws + OFF_ACT); const bf16_t* Bt = (const bf16_t*)(p.ws + OFF_WOUT);
  const float* mods = (const float*)(p.ws + OFF_MODS);
  for (int it = 0;; ++it) {
    int rowt, colt; if (!g8_tile192(it, 4, rowt, colt)) break;
    const int tid = tidx(), wid = __builtin_amdgcn_readfirstlane(tid >> 6), lane = tid & 63, wr = wid >> 2, wc = wid & 3, fr = lane & 15, fq = lane >> 4;
    const int brow = rowt * 192, bcol = colt * 256;
    g8::Acc acc;
#pragma unroll
    for (int ai = 0; ai < 2; ++ai)
#pragma unroll
      for (int bj = 0; bj < 2; ++bj)
#pragma unroll
        for (int m = 0; m < 3; ++m)
#pragma unroll
          for (int n = 0; n < 2; ++n) acc[ai][bj][m][n] = (f32x4){0.f, 0.f, 0.f, 0.f};
    __syncthreads();
    g8::kloop<3>(A, Bt, 1024, brow, bcol, (bf16_t*)lds, acc, tid);
#pragma unroll
    for (int ai = 0; ai < 2; ++ai)
#pragma unroll
      for (int m = 0; m < 3; ++m) { const int m4 = brow + ai * 96 + wr * 48 + m * 16 + fq * 4;
        const float* g1 = mods + mod_row(m4) * 6144 + 2048 + bcol + wc * 32 + fr;
        float xv[4][2][2];
#pragma unroll
        for (int j = 0; j < 4; ++j) { const float* xr = xrow(p, m4 + j) + bcol + wc * 32 + fr;
#pragma unroll
          for (int bj = 0; bj < 2; ++bj)
#pragma unroll
            for (int n = 0; n < 2; ++n) xv[j][bj][n] = xr[bj * 128 + n * 16]; }
#pragma unroll
        for (int bj = 0; bj < 2; ++bj)
#pragma unroll
          for (int n = 0; n < 2; ++n) { const float gv = g1[bj * 128 + n * 16];
#pragma unroll
            for (int j = 0; j < 4; ++j) p.out[(size_t)(m4 + j) * 1024 + bcol + bj * 128 + wc * 32 + n * 16 + fr] = xv[j][bj][n] + gv * acc[ai][bj][m][n][j]; } }
  }
}
DEV void gemm256_qp(const Params& p, unsigned char* lds) {
  const bf16_t* A = (const bf16_t*)(p.ws + OFF_ACT); const bf16_t* Bt = (const bf16_t*)(p.ws + OFF_WQ); bf16_t* dst = (bf16_t*)(p.ws + OFF_QP);
  for (int it = 0;; ++it) {
    int rowt, colt; if (!g8_tile192(it, 8, rowt, colt)) break;
    const int tid = tidx(), wid = __builtin_amdgcn_readfirstlane(tid >> 6), lane = tid & 63, wr = wid >> 2, wc = wid & 3, fr = lane & 15, fq = lane >> 4;
    const int brow = rowt * 192, bcol = colt * 256;
    g8::Acc acc;
#pragma unroll
    for (int ai = 0; ai < 2; ++ai)
#pragma unroll
      for (int bj = 0; bj < 2; ++bj)
#pragma unroll
        for (int m = 0; m < 3; ++m)
#pragma unroll
          for (int n = 0; n < 2; ++n) acc[ai][bj][m][n] = (f32x4){0.f, 0.f, 0.f, 0.f};
    __syncthreads();
    g8::kloop<3>(A, Bt, 1024, brow, bcol, (bf16_t*)lds, acc, tid);
    g8_store_tile_bf16<3>(acc, lds, dst + (size_t)brow * 2048 + bcol, 2048, tid, wr, wc, fr, fq);
  }
}

DEV float log2_sigmoid(float x) { return -log1pf(__expf(-x)) * LOG2E; }

DEV int kswz(int row) { return ((row >> 1) & 1) | (((row >> 3) & 3) << 1); }
template <bool LAT> DEV void ret_unit(const Params& p, int b, int h, int qt, unsigned char* lds) {
  constexpr bool lat = LAT;
  constexpr int T = LAT ? 1024 : 256, nkt = T >> 7;
  const int tid = tidx(), lane = tid & 63, w = __builtin_amdgcn_readfirstlane(tid >> 6), r = lane & 15, g = lane >> 4;
  const int tokbase = lat ? NCTX + b * 1024 : b * 256;
  const int t0 = qt * 256 + w * 32;
  const bf16_t* RQ = (const bf16_t*)(p.ws + OFF_RQ); const bf16_t* RK = (const bf16_t*)(p.ws + OFF_RK);
  bf16x8 qf[2][2];
#pragma unroll
  for (int qi = 0; qi < 2; ++qi) { const bf16_t* qrow = RQ + (size_t)(tokbase + t0 + qi * 16 + r) * 512 + h * 64 + g * 8; qf[qi][0] = *(const bf16x8*)qrow; qf[qi][1] = *(const bf16x8*)(qrow + 32); }
  const float l2f = log2_sigmoid(p.decay_f[h]), l2b = log2_sigmoid(p.decay_b[h]);
  f32x4 accO[2][4];
#pragma unroll
  for (int qi = 0; qi < 2; ++qi)
#pragma unroll
    for (int ni = 0; ni < 4; ++ni) accO[qi][ni] = (f32x4){0.f, 0.f, 0.f, 0.f};
  const bf16_t* kbase = RK + (size_t)tokbase * 512 + h * 64;
  const bf16_t* vtb = (const bf16_t*)(p.ws + OFF_RVT) + (lat ? LAT_VT + (size_t)(b * 8 + h) * 64 * 1024 : (size_t)(b * 8 + h) * 64 * 256);
  unsigned char* Ks = lds; unsigned char* Vs = lds + 16384;
  const int krow0 = tid >> 3, kch = tid & 7, ve0 = tid >> 4, vch = tid & 15;
  const bf16_t* kg = kbase + (size_t)krow0 * 512 + kch * 8;
  const bf16_t* vg = vtb + (size_t)ve0 * T + vch * 8;
  const int kso = krow0 * 128 + ((kch ^ kswz(krow0)) << 4), vso = ve0 * 256 + ((vch ^ (ve0 & 15)) << 4);
  u32x4 pk0 = *(const u32x4*)kg, pk1 = *(const u32x4*)(kg + (size_t)64 * 512), pv0 = *(const u32x4*)vg, pv1 = *(const u32x4*)(vg + (size_t)32 * T);
  const int kperm = 8 * (r >> 2) + (r & 3);
  const float af = ex2(l2f * (float)r), ab = ex2(l2b * (float)(15 - r));
  float cf[8], cb[8];
#pragma unroll
  for (int j = 0; j < 8; ++j) { cf[j] = ex2(l2f * (float)(7 - j)); cb[j] = ex2(l2b * (float)j); }
  for (int kt = 0; kt < nkt; ++kt) {
    __syncthreads();
    *(u32x4*)(Ks + kso) = pk0; *(u32x4*)(Ks + kso + 64 * 128) = pk1; *(u32x4*)(Vs + vso) = pv0; *(u32x4*)(Vs + vso + 32 * 256) = pv1;
    __syncthreads();
    if (kt + 1 < nkt) { const bf16_t* kn = kg + (size_t)(kt + 1) * 128 * 512; const bf16_t* vn = vg + (kt + 1) * 128;
      pk0 = *(const u32x4*)kn; pk1 = *(const u32x4*)(kn + (size_t)64 * 512); pv0 = *(const u32x4*)vn; pv1 = *(const u32x4*)(vn + (size_t)32 * T); }
#pragma unroll
    for (int k32 = 0; k32 < 4; ++k32) {
      const int ra = k32 * 32 + kperm, rb = ra + 4;
      bf16x8 a0[2], a1[2];
#pragma unroll
      for (int ks = 0; ks < 2; ++ks) { a0[ks] = *(const bf16x8*)(Ks + ra * 128 + (((ks * 4 + g) ^ kswz(ra)) << 4)); a1[ks] = *(const bf16x8*)(Ks + rb * 128 + (((ks * 4 + g) ^ kswz(rb)) << 4)); }
      bf16x8 vb[4];
#pragma unroll
      for (int ni = 0; ni < 4; ++ni) vb[ni] = *(const bf16x8*)(Vs + (ni * 16 + r) * 256 + (((k32 * 4 + g) ^ r) << 4));
      const int ks0 = kt * 128 + k32 * 32;
      const int sk0 = ks0 + g * 8;
      u32x4 pa[2];
#pragma unroll
      for (int qi = 0; qi < 2; ++qi) {
        const int tq0 = t0 + qi * 16;
        f32x4 s0 = (f32x4){0.f, 0.f, 0.f, 0.f}, s1 = s0;
        __builtin_amdgcn_s_setprio(1);
#pragma unroll
        for (int ks = 0; ks < 2; ++ks) { s0 = mfma16(a0[ks], qf[qi][ks], s0); s1 = mfma16(a1[ks], qf[qi][ks], s1); }
        __builtin_amdgcn_s_setprio(0);
        float pv[8];
        if (ks0 + 31 <= tq0) {
          const float B0 = ex2(l2f * (float)(tq0 - sk0 - 7)) * af;
#pragma unroll
          for (int reg = 0; reg < 4; ++reg) { pv[reg] = s0[reg] * (B0 * cf[reg]); pv[4 + reg] = s1[reg] * (B0 * cf[4 + reg]); }
        } else if (ks0 > tq0 + 15) {
          const float B0 = ex2(l2b * (float)(sk0 - tq0 - 15)) * ab;
#pragma unroll
          for (int reg = 0; reg < 4; ++reg) { pv[reg] = s0[reg] * (B0 * cb[reg]); pv[4 + reg] = s1[reg] * (B0 * cb[4 + reg]); }
        } else {
#pragma unroll
          for (int reg = 0; reg < 4; ++reg) {
            const int d0 = tq0 + r - (sk0 + reg), d1 = d0 - 4;
            const float w0 = d0 >= 0 ? ex2(l2f * (float)d0) : ex2(-l2b * (float)d0);
            const float w1 = d1 >= 0 ? ex2(l2f * (float)d1) : ex2(-l2b * (float)d1);
            pv[reg] = s0[reg] * w0; pv[4 + reg] = s1[reg] * w1; }
        }
        pa[qi].x = pk_bf16(pv[0], pv[1]); pa[qi].y = pk_bf16(pv[2], pv[3]); pa[qi].z = pk_bf16(pv[4], pv[5]); pa[qi].w = pk_bf16(pv[6], pv[7]);
      }
      __builtin_amdgcn_s_setprio(1);
#pragma unroll
      for (int qi = 0; qi < 2; ++qi)
#pragma unroll
        for (int ni = 0; ni < 4; ++ni) accO[qi][ni] = mfma16(mk8(pa[qi]), vb[ni], accO[qi][ni]);
      __builtin_amdgcn_s_setprio(0);
    }
  }
  if (lat) {
    const bf16_t* s0t = (const bf16_t*)(p.ws + OFF_S0T);
#pragma unroll
    for (int dir = 0; dir < 2; ++dir) {
      f32x4 a2[2][4];
#pragma unroll
      for (int qi = 0; qi < 2; ++qi)
#pragma unroll
        for (int ni = 0; ni < 4; ++ni) a2[qi][ni] = (f32x4){0.f, 0.f, 0.f, 0.f};
#pragma unroll
      for (int ks = 0; ks < 2; ++ks)
#pragma unroll
        for (int ni = 0; ni < 4; ++ni) { const bf16x8 bf = *(const bf16x8*)(s0t + ((size_t)((b * 2 + dir) * 8 + h) * 64 + ni * 16 + r) * 64 + ks * 32 + g * 8);
          a2[0][ni] = mfma16(qf[0][ks], bf, a2[0][ni]); a2[1][ni] = mfma16(qf[1][ks], bf, a2[1][ni]); }
#pragma unroll
      for (int qi = 0; qi < 2; ++qi)
#pragma unroll
        for (int reg = 0; reg < 4; ++reg) { const int tt = t0 + qi * 16 + g * 4 + reg; const float fac = dir == 0 ? ex2(l2f * (float)(tt + 1)) : ex2(l2b * (float)(T - tt));
#pragma unroll
          for (int ni = 0; ni < 4; ++ni) accO[qi][ni][reg] += fac * a2[qi][ni][reg]; }
    }
  }
  const bf16_t* RG = (const bf16_t*)(p.ws + OFF_RG); bf16_t* cat = (bf16_t*)(p.ws + OFF_ACT);
  float gn[4];
#pragma unroll
  for (int ni = 0; ni < 4; ++ni) gn[ni] = p.gn_g[h * 64 + ni * 16 + r];
#pragma unroll
  for (int qi = 0; qi < 2; ++qi)
#pragma unroll
    for (int reg = 0; reg < 4; ++reg) {
      float ss = 0.f;
#pragma unroll
      for (int ni = 0; ni < 4; ++ni) ss += accO[qi][ni][reg] * accO[qi][ni][reg];
      ss = row16_sum(ss);
      const float rstd = rsqrtf(ss * (1.f / 64.f) + EPSF);
      const size_t m = (size_t)(tokbase + t0 + qi * 16 + g * 4 + reg);
#pragma unroll
      for (int ni = 0; ni < 4; ++ni) { const int e = ni * 16 + r; const float gate = bf2f(RG[m * 512 + h * 64 + e]);
        cat[m * 1024 + h * 64 + e] = f2bf(gate * accO[qi][ni][reg] * rstd * gn[ni]); }
    }
}

DEV void state_unit(const Params& p, int b, int h) {
  const int tid = tidx(), lane = tid & 63, w = __builtin_amdgcn_readfirstlane(tid >> 6), r = lane & 15, g = lane >> 4;
  const int dir = w >> 2, dt = w & 3;
  const float l2 = dir == 0 ? log2_sigmoid(p.decay_f[h]) : log2_sigmoid(p.decay_b[h]);
  const bf16_t* kt = (const bf16_t*)(p.ws + OFF_KT) + (size_t)(b * 8 + h) * 64 * 256;
  const bf16_t* vt = (const bf16_t*)(p.ws + OFF_RVT) + (size_t)(b * 8 + h) * 64 * 256;
  f32x4 acc[4];
#pragma unroll
  for (int ni = 0; ni < 4; ++ni) acc[ni] = (f32x4){0.f, 0.f, 0.f, 0.f};
  for (int s32 = 0; s32 < 8; ++s32) {
    const u32x4 raw = *(const u32x4*)(kt + (size_t)(dt * 16 + r) * 256 + s32 * 32 + g * 8);
    const int sb = s32 * 32 + g * 8;
    float wv[8];
#pragma unroll
    for (int j = 0; j < 8; ++j) wv[j] = dir == 0 ? ex2(l2 * (float)(255 - sb - j)) : ex2(l2 * (float)(sb + j));
    u32x4 a; a.x = pk_bf16(bf_lo(raw.x) * wv[0], bf_hi(raw.x) * wv[1]); a.y = pk_bf16(bf_lo(raw.y) * wv[2], bf_hi(raw.y) * wv[3]);
    a.z = pk_bf16(bf_lo(raw.z) * wv[4], bf_hi(raw.z) * wv[5]); a.w = pk_bf16(bf_lo(raw.w) * wv[6], bf_hi(raw.w) * wv[7]);
#pragma unroll
    for (int ni = 0; ni < 4; ++ni) { const bf16x8 bfr = *(const bf16x8*)(vt + (size_t)(ni * 16 + r) * 256 + s32 * 32 + g * 8); acc[ni] = mfma16(mk8(a), bfr, acc[ni]); }
  }
  float* o = p.out + OUT_ST + (size_t)((b * 2 + dir) * 8 + h) * 4096;
#pragma unroll
  for (int ni = 0; ni < 4; ++ni)
#pragma unroll
    for (int reg = 0; reg < 4; ++reg) o[(dt * 16 + g * 4 + reg) * 64 + ni * 16 + r] = acc[ni][reg];
}

template <bool LAT> DEV void attn_wave(const Params& p, int b, int h, int qtok  , int rq, int c0, const float* rpb_l, int lane, const unsigned char* kl, const unsigned char* vl,
                                      const unsigned char* kw = nullptr  , int rb = 0  ) {
  constexpr int NCH = LAT ? 2 : 1;
  const int r = lane & 15, g = lane >> 4;
  const bf16_t* NQ = (const bf16_t*)(p.ws + OFF_NQ); const bf16_t* NK = (const bf16_t*)(p.ws + OFF_NK);
  const bf16_t* CK = (const bf16_t*)(p.ws + OFF_CK);
  const bf16_t* NVT = (const bf16_t*)(p.ws + OFF_NVT); const bf16_t* CVT = (const bf16_t*)(p.ws + OFF_CVT);
  const bf16_t* qrow = NQ + (size_t)(qtok + r) * 512 + h * 64 + g * 8;
  bf16x8 qf[2]; qf[0] = *(const bf16x8*)qrow; qf[1] = *(const bf16x8*)(qrow + 32);
  const int rs = LAT ? min(max(rq - 4, 0), 8) : 0;
  const int cs = LAT ? (c0 == 0 ? 0 : (c0 == 48 ? 32 : c0 - 8)) : 0;
  const int latbase = NCTX + b * 1024;
  const int krow_in_step = 8 * (r >> 2) + (r & 3);
  f32x4 accO[4];
#pragma unroll
  for (int ni = 0; ni < 4; ++ni) accO[ni] = (f32x4){0.f, 0.f, 0.f, 0.f};
  float m_run = -3e38f, l_run = 0.f;
#pragma unroll
  for (int ch = 0; ch < NCH; ++ch) {
    const bool win = LAT && ch == 0;
    const bf16_t* kb; size_t kstep;
    if (win) { kb = NK + (size_t)(latbase + rs * 64 + cs + krow_in_step) * 512 + h * 64 + g * 8; kstep = (size_t)64 * 512; }
    else if (LAT) { kb = CK + ((size_t)(b * 256 + krow_in_step) * 8 + h) * 64 + g * 8; kstep = (size_t)32 * 512; }
    else { kb = NK + (size_t)(b * 256 + krow_in_step) * 512 + h * 64 + g * 8; kstep = (size_t)32 * 512; }
    const size_t kodd = win ? (size_t)4 * 512 : (size_t)4 * 512;
    f32x4 s[16];
    {
      bf16x8 ka[2][4][2];
      const bool from_lds = !win;
#define LOADK(dst, j) do { if (from_lds) { const int krw = ((j) >> 1) * 32 + krow_in_step + ((j) & 1) * 4; \
          (dst)[0] = *(const bf16x8*)(kl + krw * 128 + ((g ^ kswz(krw)) << 4)); (dst)[1] = *(const bf16x8*)(kl + krw * 128 + (((4 + g) ^ kswz(krw)) << 4)); } \
        else if (LAT) { const int krw = (rs - rb + ((j) >> 1)) * 64 + cs + krow_in_step + ((j) & 1) * 4; const int sw = kswz(krw); \
          (dst)[0] = *(const bf16x8*)(kw + krw * 128 + ((g ^ sw) << 4)); (dst)[1] = *(const bf16x8*)(kw + krw * 128 + (((4 + g) ^ sw) << 4)); } \
        else { const bf16_t* kp = kb + (size_t)((j) >> 1) * kstep + ((j) & 1) * kodd; (dst)[0] = *(const bf16x8*)kp; (dst)[1] = *(const bf16x8*)(kp + 32); } } while (0)
#pragma unroll
      for (int jj = 0; jj < 4; ++jj) LOADK(ka[0][jj], jj);
#pragma unroll
      for (int hb = 0; hb < 4; ++hb) {
        if (hb < 3) {
#pragma unroll
          for (int jj = 0; jj < 4; ++jj) LOADK(ka[(hb + 1) & 1][jj], (hb + 1) * 4 + jj);
        }
        __builtin_amdgcn_sched_barrier(0);
        __builtin_amdgcn_s_setprio(1);
#pragma unroll
        for (int jj = 0; jj < 4; ++jj) { f32x4 t = (f32x4){0.f, 0.f, 0.f, 0.f}; t = mfma16(ka[hb & 1][jj][0], qf[0], t); t = mfma16(ka[hb & 1][jj][1], qf[1], t); s[hb * 4 + jj] = t; }
        __builtin_amdgcn_s_setprio(0);
        __builtin_amdgcn_sched_barrier(0);
      }
    }
    const bf16_t* vb; size_t vstep, vd;
    if (win) { vb = NVT + LAT_VT + ((size_t)(b * 8 + h) * 64 + r) * 1024 + rs * 64 + cs + g * 8; vstep = 64; vd = (size_t)16 * 1024; }
    else if (LAT) { vb = CVT + ((size_t)(b * 8 + h) * 64 + r) * 256 + g * 8; vstep = 32; vd = (size_t)16 * 256; }
    else { vb = NVT + ((size_t)(b * 8 + h) * 64 + r) * 256 + g * 8; vstep = 32; vd = (size_t)16 * 256; }
    bf16x8 va[4][4];
    const bool vfrom_lds = !win;
#define LOADV(kk, ni) (vfrom_lds ? *(const bf16x8*)(vl + ((ni) * 16 + r) * 512 + ((((kk) * 4 + g) ^ r) << 4)) : *(const bf16x8*)(vb + (size_t)(kk) * vstep + (ni) * vd))
#pragma unroll
    for (int kk = 0; kk < 4; ++kk)
#pragma unroll
      for (int ni = 0; ni < 4; ++ni) va[kk][ni] = LOADV(kk, ni);
    if (win) {
      const int qc = c0 + r, cst = min(max(qc - 8, 0), 48);
#pragma unroll
      for (int j = 0; j < 16; ++j) { const int dr = rs + (j >> 1) - rq + 7;
#pragma unroll
        for (int reg = 0; reg < 4; ++reg) { const int kc = cs + 8 * g + reg + 4 * (j & 1); const bool inw = (kc >= cst) && (kc < cst + 16);
          const int dc = min(max(kc - qc + 15, 0), 30);
          s[j][reg] = inw ? s[j][reg] + rpb_l[dr * 31 + dc] : -1e30f; } }
    }
    float mc = -3e38f;
#pragma unroll
    for (int j = 0; j < 16; ++j)
#pragma unroll
      for (int reg = 0; reg < 4; ++reg) mc = fmaxf(mc, s[j][reg]);
    mc = rows_max(mc);
    const float m_new = fmaxf(m_run, mc);
    const float alpha = ex2((m_run - m_new) * LOG2E);
    const float mnl = -m_new * LOG2E;
    float sum = 0.f;
#pragma unroll
    for (int j = 0; j < 16; ++j)
#pragma unroll
      for (int reg = 0; reg < 4; ++reg) { const float ev = ex2(__builtin_fmaf(s[j][reg], LOG2E, mnl)); s[j][reg] = ev; sum += ev; }
    sum = rows_sum(sum);
    l_run = l_run * alpha + sum; m_run = m_new;
    if (ch > 0) {
#pragma unroll
      for (int reg = 0; reg < 4; ++reg) { const float ar = __shfl(alpha, g * 4 + reg);
#pragma unroll
        for (int ni = 0; ni < 4; ++ni) accO[ni][reg] *= ar; }
    }
#pragma unroll
    for (int hb = 0; hb < 2; ++hb) {
      if (hb == 1) {
#pragma unroll
        for (int kk = 0; kk < 4; ++kk)
#pragma unroll
          for (int ni = 0; ni < 4; ++ni) va[kk][ni] = LOADV(4 + kk, ni);
      }
#pragma unroll
      for (int k4 = 0; k4 < 4; ++k4) { const int kk = hb * 4 + k4;
        u32x4 pa; pa.x = pk_bf16(s[2 * kk][0], s[2 * kk][1]); pa.y = pk_bf16(s[2 * kk][2], s[2 * kk][3]);
        pa.z = pk_bf16(s[2 * kk + 1][0], s[2 * kk + 1][1]); pa.w = pk_bf16(s[2 * kk + 1][2], s[2 * kk + 1][3]);
        __builtin_amdgcn_s_setprio(1);
#pragma unroll
        for (int ni = 0; ni < 4; ++ni) accO[ni] = mfma16(mk8(pa), va[k4][ni], accO[ni]);
        __builtin_amdgcn_s_setprio(0); }
    }
  }
  const float inv = rcpf_fast(l_run);
  bf16_t* cat = (bf16_t*)(p.ws + OFF_ACT);
#pragma unroll
  for (int reg = 0; reg < 4; ++reg) { const size_t m = (size_t)(qtok + g * 4 + reg); const float ir = __shfl(inv, g * 4 + reg);
#pragma unroll
    for (int ni = 0; ni < 4; ++ni) cat[m * 1024 + 512 + h * 64 + ni * 16 + r] = f2bf(accO[ni][reg] * ir); }
}

DEV void stage_kv256(const bf16_t* ksrc, const bf16_t* vsrc, unsigned char* kl, unsigned char* vl, int tid) {
  u32x4 kr[4], vr[4];
#pragma unroll
  for (int i = 0; i < 4; ++i) { const int sl = tid + 512 * i; kr[i] = *(const u32x4*)(ksrc + (size_t)(sl >> 3) * 512 + (sl & 7) * 8); vr[i] = *(const u32x4*)(vsrc + (size_t)(sl >> 5) * 256 + (sl & 31) * 8); }
#pragma unroll
  for (int i = 0; i < 4; ++i) { const int sl = tid + 512 * i; const int row = sl >> 3, ch = sl & 7;
    *(u32x4*)(kl + row * 128 + ((ch ^ kswz(row)) << 4)) = kr[i];
    *(u32x4*)(vl + (sl >> 5) * 512 + (((sl & 31) ^ ((sl >> 5) & 15)) << 4)) = vr[i]; }
}
DEV void phase3(const Params& p, unsigned char* lds) {
  const bool hx = gridDim.x == 256; const int gx = __builtin_amdgcn_readfirstlane((int)(blockIdx.x & 7)), gj = __builtin_amdgcn_readfirstlane((int)(blockIdx.x >> 3));
  for (int u = blockIdx.x; u < 1280; u += gridDim.x) {
    const int tid = tidx(), lane = tid & 63, w = __builtin_amdgcn_readfirstlane(tid >> 6);
    if (u < 256) ret_unit<true>(p, hx ? gj >> 2 : u >> 5, hx ? gx : (u >> 2) & 7, hx ? gj & 3 : u & 3, lds);
    else if (u < 768) { const int u2 = u - 256; const int b = hx ? gj >> 2 : u2 >> 6, h = hx ? gx : (u2 >> 3) & 7, rp = hx ? (gj & 3) * 2 + (u2 >> 8) : u2 & 7;
      float* rl = (float*)lds; unsigned char* kl = lds + 2048; unsigned char* vl = kl + 32768; unsigned char* kw = lds + 68608;
      const int rb = min(max(2 * rp - 4, 0), 7);
      __syncthreads();
      { const bf16_t* ksrc = (const bf16_t*)(p.ws + OFF_NK) + (size_t)(NCTX + b * 1024 + rb * 64) * 512 + h * 64;
        u32x4 kr[9];
#pragma unroll
        for (int i = 0; i < 9; ++i) { const int sl = tid + 512 * i; kr[i] = *(const u32x4*)(ksrc + (size_t)(sl >> 3) * 512 + (sl & 7) * 8); }
        for (int i = tid; i < 465; i += 512) rl[i] = p.rpb[h * 465 + i];
        stage_kv256((const bf16_t*)(p.ws + OFF_CK) + (size_t)b * 256 * 512 + h * 64, (const bf16_t*)(p.ws + OFF_CVT) + (size_t)(b * 8 + h) * 64 * 256, kl, vl, tid);
#pragma unroll
        for (int i = 0; i < 9; ++i) { const int sl = tid + 512 * i; const int key = sl >> 3, ch = sl & 7; *(u32x4*)(kw + key * 128 + ((ch ^ kswz(key)) << 4)) = kr[i]; } }
      __syncthreads();
      const int rq = 2 * rp + (w >> 2), c0 = (w & 3) * 16;
      attn_wave<true>(p, b, h, NCTX + b * 1024 + rq * 64 + c0, rq, c0, rl, lane, kl, vl, kw, rb); }
    else if (u < 896) { const int u2 = u - 768; ret_unit<false>(p, u2 >> 3, u2 & 7, 0, lds); }
    else if (u < 1152) { const int u2 = u - 896; const int b = hx ? gj & 15 : u2 >> 4, h = hx ? gx : (u2 >> 1) & 7, qt = hx ? (gj < 16 ? 1 : 0) : u2 & 1;
      unsigned char* kl = lds + 2048; unsigned char* vl = kl + 32768;
      __syncthreads();
      stage_kv256((const bf16_t*)(p.ws + OFF_NK) + (size_t)b * 256 * 512 + h * 64, (const bf16_t*)(p.ws + OFF_NVT) + (size_t)(b * 8 + h) * 64 * 256, kl, vl, tid);
      __syncthreads();
      attn_wave<false>(p, b, h, b * 256 + qt * 128 + w * 16, 0, 0, nullptr, lane, kl, vl); }
    else { const int u2 = u - 1152; state_unit(p, u2 >> 3, u2 & 7); }
  }
}

struct PairTab { int a[64]; int b[64]; };
constexpr PairTab make_pairs() { PairTab t{}; int n = 0; for (int a = 0; a < 16; ++a) for (int b = 0; b < 16; ++b) if ((a + 1) * (b + 1) <= 16) { t.a[n] = a; t.b[n] = b; ++n; }
  for (; n < 64; ++n) { t.a[n] = -1; t.b[n] = -1; } return t; }
template <int GRP> DEV void build_q(const float (&t1)[16], const float (&t2)[16], float (&q)[16]) {
  constexpr PairTab PT = make_pairs();
#pragma unroll
  for (int i = 0; i < 16; ++i) {
    constexpr int dummy = 0; (void)dummy;
    const int a = PT.a[GRP * 16 + i], bb = PT.b[GRP * 16 + i];
    if (a >= 0) { const float sum = __uint_as_float(__float_as_uint(t1[a]) & ~0x7Fu) + __uint_as_float(__float_as_uint(t2[bb]) & ~0x7Fu);
      q[i] = __uint_as_float((__float_as_uint(sum) & ~0xFFu) | (unsigned)(a * 16 + bb)); }
    else q[i] = -3.0e38f;
  }
}
DEV void peer_select_wave(const Params& p, int tg, int hd, int tid, int lane, int* ldsw, unsigned char* klds) {
  const int r = lane & 15, g = lane >> 4; const int m = tg * 16 + r;
  const bf16_t* QP = (const bf16_t*)(p.ws + OFF_QP); const bf16_t* KEYS = (const bf16_t*)(p.ws + OFF_KEYS);
  float t1[16], t2[16];
  bf16x8 bqa[2][4];
#pragma unroll
  for (int half = 0; half < 2; ++half)
#pragma unroll
    for (int ks = 0; ks < 4; ++ks) bqa[half][ks] = *(const bf16x8*)(QP + (size_t)m * 2048 + hd * 256 + half * 128 + ks * 32 + g * 8);
#pragma unroll
  for (int half = 0; half < 2; ++half) {
    const bf16x8 (&bq)[4] = bqa[half];
    const unsigned char* klh = klds + half * 32768;
    f32x4 s[8];
#pragma unroll
    for (int j = 0; j < 8; ++j) s[j] = (f32x4){0.f, 0.f, 0.f, 0.f};
#pragma unroll
    for (int ks = 0; ks < 4; ++ks)
#pragma unroll
      for (int j = 0; j < 8; ++j) { const bf16x8 ak = *(const bf16x8*)(klh + (j * 16 + r) * 256 + (((ks * 4 + g) ^ r) << 4)); s[j] = mfma16(ak, bq[ks], s[j]); }
    float v[32];
#pragma unroll
    for (int j = 0; j < 8; ++j)
#pragma unroll
      for (int reg = 0; reg < 4; ++reg) v[j * 4 + reg] = __uint_as_float((__float_as_uint(s[j][reg]) & ~0x7Fu) | (unsigned)(j * 16 + g * 4 + reg));
    bitonic_sort_desc<32>(v);
    float t[16];
#pragma unroll
    for (int i = 0; i < 16; ++i) t[i] = v[i];
#pragma unroll
    for (int step = 16; step <= 32; step <<= 1) { float o[16];
#pragma unroll
      for (int i = 0; i < 16; ++i) o[i] = __shfl_xor(t[i], step);
      top16_merge(t, o); }
#pragma unroll
    for (int i = 0; i < 16; ++i) { if (half == 0) t1[i] = t[i]; else t2[i] = t[i]; }
  }
  if (g == 0) {
#pragma unroll
    for (int i = 0; i < 16; ++i) { ldsw[r * 32 + i] = (int)(__float_as_uint(t1[i]) & 0x7Fu); ldsw[r * 32 + 16 + i] = (int)(__float_as_uint(t2[i]) & 0x7Fu); }
  }
  float q0[16];
  build_q<0>(t1, t2, q0); bitonic_sort_desc<16>(q0);
  { float q1[16]; build_q<1>(t1, t2, q1); bitonic_sort_desc<16>(q1); top16_merge(q0, q1); }
  { float q2[16]; build_q<2>(t1, t2, q2); bitonic_sort_desc<16>(q2);
    { float q3[16]; build_q<3>(t1, t2, q3); bitonic_sort_desc<16>(q3); top16_merge(q2, q3); }
    top16_merge(q0, q2); }
  const float mx = __uint_as_float(__float_as_uint(q0[0]) & ~0xFFu);
  float ev[16], sum = 0.f;
#pragma unroll
  for (int i = 0; i < 16; ++i) { ev[i] = ex2((__uint_as_float(__float_as_uint(q0[i]) & ~0xFFu) - mx) * LOG2E); sum += ev[i]; }
  const float inv = rcpf_fast(sum);
  asm volatile("s_waitcnt lgkmcnt(0)" ::: "memory");
  __builtin_amdgcn_wave_barrier();
  unsigned short* LE = (unsigned short*)(p.ws + OFF_LE); _Float16* LG = (_Float16*)(p.ws + OFF_LG);
#pragma unroll
  for (int i = 0; i < 16; ++i) if ((i >> 2) == g) { const unsigned code = __float_as_uint(q0[i]) & 0xFFu;
      const int i1 = ldsw[r * 32 + (code >> 4)], i2 = ldsw[r * 32 + 16 + (code & 15)];
      LE[(size_t)m * 128 + hd * 16 + i] = (unsigned short)(i1 * 128 + i2); LG[(size_t)m * 128 + hd * 16 + i] = (_Float16)(ev[i] * inv); }
  asm volatile("s_waitcnt lgkmcnt(0)" ::: "memory");
  __builtin_amdgcn_wave_barrier();
}
DEV void phase7(const Params& p, unsigned char* lds) {
  const int tid = tidx(), lane = tid & 63, w = tid >> 6;
  int cur_hd = -1;
  const bool grouped = gridDim.x == 256; const int gg = __builtin_amdgcn_readfirstlane((int)(blockIdx.x & 7)), gj = __builtin_amdgcn_readfirstlane((int)(blockIdx.x >> 3));
  for (int un = grouped ? 0 : blockIdx.x; un < (grouped ? 3 : 768); un += grouped ? 1 : gridDim.x) {
    const int unit = grouped ? ((12 * gg + (gj >> 3) + 4 * un) << 3) | (gj & 7) : un;
    const int hd = unit & 7;
    if (hd != cur_hd) {
      const bf16_t* ksrc = (const bf16_t*)(p.ws + OFF_KEYS) + (size_t)hd * 2 * 128 * 128;
      u32x4 kr[8];
#pragma unroll
      for (int i = 0; i < 8; ++i) { const int sl = tid + 512 * i; kr[i] = *(const u32x4*)(ksrc + (size_t)sl * 8); }
      __syncthreads();
#pragma unroll
      for (int i = 0; i < 8; ++i) { const int sl = tid + 512 * i, row = sl >> 4, ch = sl & 15; *(u32x4*)(lds + row * 256 + ((ch ^ (row & 15)) << 4)) = kr[i]; }
      __syncthreads();
      cur_hd = hd; }
    peer_select_wave(p, (unit >> 3) * 8 + w, hd, tid, lane, (int*)(lds + 65536 + w * 2048), lds);
  }
}

DEV void unpack_fp8(const u32x4& r, f32x2 (&f)[8]) {
  f[0] = __builtin_amdgcn_cvt_pk_f32_fp8((int)r.x, false); f[1] = __builtin_amdgcn_cvt_pk_f32_fp8((int)r.x, true);
  f[2] = __builtin_amdgcn_cvt_pk_f32_fp8((int)r.y, false); f[3] = __builtin_amdgcn_cvt_pk_f32_fp8((int)r.y, true);
  f[4] = __builtin_amdgcn_cvt_pk_f32_fp8((int)r.z, false); f[5] = __builtin_amdgcn_cvt_pk_f32_fp8((int)r.z, true);
  f[6] = __builtin_amdgcn_cvt_pk_f32_fp8((int)r.w, false); f[7] = __builtin_amdgcn_cvt_pk_f32_fp8((int)r.w, true);
}
struct PeerMap { int vx, nx, tbeg, tend; };
DEV PeerMap peer_map(const Params& p, unsigned xcc, unsigned nloc, unsigned* lds_word) {
  unsigned* bar = (unsigned*)(p.ws + OFF_BAR);
  PeerMap M; M.vx = 0; M.nx = 0;
#pragma unroll
  for (unsigned j = 0; j < 16; ++j) { const unsigned c = __hip_atomic_load(&bar[256 + 64 * j], __ATOMIC_RELAXED, __HIP_MEMORY_SCOPE_AGENT); if (c > 0u) { if (j < xcc) ++M.vx; ++M.nx; } }
  __syncthreads();
  if (threadIdx.x == 0) *lds_word = __hip_atomic_fetch_add(&bar[3456 + 64 * xcc], 1u, __ATOMIC_RELAXED, __HIP_MEMORY_SCOPE_AGENT);
  __syncthreads();
  const unsigned rank = (unsigned)__builtin_amdgcn_readfirstlane((int)(*lds_word % nloc));
  M.tbeg = (int)((long)rank * NTOK / nloc); M.tend = (int)((long)(rank + 1) * NTOK / nloc);
  M.vx = __builtin_amdgcn_readfirstlane(M.vx); M.nx = __builtin_amdgcn_readfirstlane(M.nx); M.tbeg = __builtin_amdgcn_readfirstlane(M.tbeg); M.tend = __builtin_amdgcn_readfirstlane(M.tend);
  return M;
}
DEV void peer_ld_rows(const __amdgpu_buffer_rsrc_t T, const int* le_lds, int p8, int c, u32x4 (&R)[16]) {
#pragma unroll
  for (int j = 0; j < 16; ++j) R[j] = __builtin_amdgcn_raw_buffer_load_b128(T, le_lds[p8 * 16 + j] * 128 + c * 16, 0, 0);
}
template <int CTRL, int BANK = 0xf> DEV float dpp_mov(float old, float src) { return __int_as_float(__builtin_amdgcn_update_dpp(__float_as_int(old), __float_as_int(src), CTRL, 0xf, BANK, false)); }
DEV float xchg_xor4(float v) { float r = dpp_mov<0x104, 0x5>(v, v); return dpp_mov<0x114, 0xA>(r, v); }
DEV float rs_swap16(float even, float odd) { const u32x2 s = __builtin_amdgcn_permlane16_swap(__float_as_uint(even), __float_as_uint(odd), false, false); return __uint_as_float(s.x) + __uint_as_float(s.y); }
DEV float rs_swap32(float even, float odd) { const u32x2 s = __builtin_amdgcn_permlane32_swap(__float_as_uint(even), __float_as_uint(odd), false, false); return __uint_as_float(s.x) + __uint_as_float(s.y); }
DEV void peer_u_token(const u32x4 (&R)[16], const u32x4& hq, _Float16* part_n, int lane) {
  float a[16];
#pragma unroll
  for (int j = 0; j < 16; ++j) { int d = __builtin_amdgcn_sdot4((int)R[j].x, (int)hq.x, 0, false); d = __builtin_amdgcn_sdot4((int)R[j].y, (int)hq.y, d, false);
    d = __builtin_amdgcn_sdot4((int)R[j].z, (int)hq.z, d, false); d = __builtin_amdgcn_sdot4((int)R[j].w, (int)hq.w, d, false); a[j] = (float)d; }
  const bool b0 = (lane & 1) != 0, b1 = (lane & 2) != 0, b2 = (lane & 4) != 0;
  float t[8], u[4], v[2];
#pragma unroll
  for (int k = 0; k < 8; ++k) { const float snd = b0 ? a[2 * k] : a[2 * k + 1]; t[k] = (b0 ? a[2 * k + 1] : a[2 * k]) + dpp_mov<0xB1>(snd, snd); }
#pragma unroll
  for (int k = 0; k < 4; ++k) { const float snd = b1 ? t[2 * k] : t[2 * k + 1]; u[k] = (b1 ? t[2 * k + 1] : t[2 * k]) + dpp_mov<0x4E>(snd, snd); }
#pragma unroll
  for (int k = 0; k < 2; ++k) v[k] = (b2 ? u[2 * k + 1] : u[2 * k]) + xchg_xor4(b2 ? u[2 * k] : u[2 * k + 1]);
  const int p8 = lane >> 3, c = lane & 7;
  part_n[8 * c + p8] = (_Float16)(v[0] * 0.015625f); part_n[64 + 8 * c + p8] = (_Float16)(v[1] * 0.015625f);
}
DEV void peer_v_token(const u32x4 (&R)[16], const float* cf_lds, float* out_n, const float* g2_n, int lane) {
  const int p8 = lane >> 3, c = lane & 7;
  const int c0 = 16 * c + p8, c1 = c0 + 8;
  const float x0 = out_n[c0], x1 = out_n[c1], gg0 = g2_n[c0], gg1 = g2_n[c1];
  f32x2 acc[8];
#pragma unroll
  for (int q = 0; q < 8; ++q) acc[q] = (f32x2){0.f, 0.f};
#pragma unroll
  for (int j = 0; j < 16; ++j) { f32x2 f[8]; unpack_fp8(R[j], f); const float cj = cf_lds[p8 * 16 + j]; const f32x2 w = {cj, cj};
#pragma unroll
    for (int q = 0; q < 8; ++q) acc[q] = __builtin_elementwise_fma(f[q], w, acc[q]); }
  float a[16];
#pragma unroll
  for (int q = 0; q < 8; ++q) { a[2 * q] = acc[q].x; a[2 * q + 1] = acc[q].y; }
  const bool b3 = (lane & 8) != 0, b4 = (lane & 16) != 0, b5 = (lane & 32) != 0;
  float t[8], u[4], v[2];
#pragma unroll
  for (int k = 0; k < 8; ++k) { const float snd = b3 ? a[2 * k] : a[2 * k + 1]; t[k] = (b3 ? a[2 * k + 1] : a[2 * k]) + dpp_mov<0x128>(snd, snd); }
#pragma unroll
  for (int k = 0; k < 4; ++k) u[k] = rs_swap16(t[2 * k], t[2 * k + 1]);
#pragma unroll
  for (int k = 0; k < 2; ++k) v[k] = rs_swap32(u[2 * k], u[2 * k + 1]);
  out_n[c0] = x0 + gg0 * v[0]; out_n[c1] = x1 + gg1 * v[1];
}
template <bool VSIDE> DEV void phase8ab(const Params& p, const PeerMap& M, int tid, unsigned char* lds) {
  static_assert(!VSIDE, "U side only");
  const int lane = tid & 63, w = tid >> 6, p8 = lane >> 3, c = lane & 7;
  const unsigned* LE = (const unsigned*)(p.ws + OFF_LE); const float* CF = nullptr;
  int* li = (int*)(lds + w * 4096); float* lc = (float*)(lds + w * 4096 + 2048);
  const int tp0 = ((2 * lane) & 7) * 16 + (lane >> 2);
  const int K = (M.tend - M.tbeg - w + 7) / 8;
  for (int s = M.vx; s < 8; s += M.nx) {
    const __amdgpu_buffer_rsrc_t T = __builtin_amdgcn_make_buffer_rsrc((void*)(p.ws + (VSIDE ? OFF_V : OFF_U) + (size_t)s * 16384 * 128), 0, 16384 * 128, 0x00020000);
    const unsigned char* H8s = p.ws + OFF_H8 + (size_t)s * 12288 * 128;
    _Float16* part = (_Float16*)(p.ws + OFF_PART) + (size_t)s * 12288 * 128;
    int pe[8]; float pc[8];
#pragma unroll
    for (int q = 0; q < 4; ++q) { const int n = M.tbeg + w + 8 * q; const bool ok = q < K; const size_t o = (size_t)(ok ? n : M.tbeg) * 64;
      pe[2 * q] = (int)LE[o + lane]; }
    for (int k0 = 0; k0 < K; k0 += 4) {
      asm volatile("s_waitcnt lgkmcnt(0)" ::: "memory"); __builtin_amdgcn_wave_barrier();
#pragma unroll
      for (int q = 0; q < 4; ++q) { i32x2 ev2; ev2.x = pe[2 * q] & 0xffff; ev2.y = (int)((unsigned)pe[2 * q] >> 16); li[q * 128 + tp0] = ev2.x; li[q * 128 + tp0 + 16] = ev2.y; }
      asm volatile("s_waitcnt lgkmcnt(0)" ::: "memory"); __builtin_amdgcn_wave_barrier();
#pragma unroll
      for (int q = 0; q < 4; ++q) { const int kk = k0 + 4 + q; const bool ok = kk < K; const size_t o = (size_t)(ok ? M.tbeg + w + 8 * kk : M.tbeg) * 64;
        pe[2 * q] = (int)LE[o + lane]; }
      const int nt = min(4, K - k0);
      const int nb = M.tbeg + w + 8 * k0;
      u32x4 RA[16], RB[16];
      u32x4 hq4[4];
#pragma unroll
      for (int q = 0; q < 4; ++q) hq4[q] = *(const u32x4*)(H8s + (size_t)(q < nt ? nb + 8 * q : nb) * 128 + c * 16);
      __builtin_amdgcn_s_setprio(2);
      peer_ld_rows(T, li, p8, c, RA);
      if (nt > 1) peer_ld_rows(T, li + 128, p8, c, RB);
      __builtin_amdgcn_s_setprio(0);
      if (VSIDE) peer_v_token(RA, lc, p.out + (size_t)nb * 1024 + s * 128, (const float*)(p.ws + OFF_MODS) + mod_row(nb) * 6144 + 5 * 1024 + s * 128, lane);
      else peer_u_token(RA, hq4[0], part + (size_t)nb * 128, lane);
      __builtin_amdgcn_s_setprio(2);
      if (nt > 2) peer_ld_rows(T, li + 256, p8, c, RA);
      __builtin_amdgcn_s_setprio(0);
      if (nt > 1) { const int n = nb + 8;
        if (VSIDE) peer_v_token(RB, lc + 128, p.out + (size_t)n * 1024 + s * 128, (const float*)(p.ws + OFF_MODS) + mod_row(n) * 6144 + 5 * 1024 + s * 128, lane);
        else peer_u_token(RB, hq4[1], part + (size_t)n * 128, lane); }
      __builtin_amdgcn_s_setprio(2);
      if (nt > 3) peer_ld_rows(T, li + 384, p8, c, RB);
      __builtin_amdgcn_s_setprio(0);
      if (nt > 2) { const int n = nb + 16;
        if (VSIDE) peer_v_token(RA, lc + 256, p.out + (size_t)n * 1024 + s * 128, (const float*)(p.ws + OFF_MODS) + mod_row(n) * 6144 + 5 * 1024 + s * 128, lane);
        else peer_u_token(RA, hq4[2], part + (size_t)n * 128, lane); }
      if (nt > 3) { const int n = nb + 24;
        if (VSIDE) peer_v_token(RB, lc + 384, p.out + (size_t)n * 1024 + s * 128, (const float*)(p.ws + OFF_MODS) + mod_row(n) * 6144 + 5 * 1024 + s * 128, lane);
        else peer_u_token(RB, hq4[3], part + (size_t)n * 128, lane); }
    }
  }
}
DEV void phase8r(const Params& p) {
  const unsigned* LE2 = (const unsigned*)(p.ws + OFF_LE); const unsigned* LG2 = (const unsigned*)(p.ws + OFF_LG);
  const float* SU = (const float*)(p.ws + OFF_SU); const float* SV = (const float*)(p.ws + OFF_SV); const float* SH = (const float*)(p.ws + OFF_SH);
  const unsigned* part2 = (const unsigned*)(p.ws + OFF_PART); unsigned* coef2 = (unsigned*)(p.ws + OFF_COEF);
  const int nthr = gridDim.x * 512;
  constexpr int ND = NTOK * 64;
  for (int base = blockIdx.x * 512 + threadIdx.x; base < ND; base += 3 * nthr) {
    unsigned pr[3][8]; unsigned e[3], g[3];
#pragma unroll
    for (int q = 0; q < 3; ++q) { const int idx = base + q * nthr; const int id = idx < ND ? idx : 0;
      e[q] = LE2[id]; g[q] = LG2[id];
#pragma unroll
      for (int x = 0; x < 8; ++x) pr[q][x] = part2[(size_t)x * ND + id]; }
#pragma unroll
    for (int q = 0; q < 3; ++q) { const int idx = base + q * nthr;
      if (idx < ND) { float s0 = 0.f, s1 = 0.f;
#pragma unroll
        for (int x = 0; x < 8; ++x) { const f16x2 hv = __builtin_bit_cast(f16x2, pr[q][x]); s0 += (float)hv.x; s1 += (float)hv.y; }
        const float sh = SH[idx >> 6] * 64.f;
        const int e0 = (int)(e[q] & 0xffffu), e1 = (int)(e[q] >> 16); const f16x2 gh = __builtin_bit_cast(f16x2, g[q]);
        f16x2 o; o.x = (_Float16)((float)gh.x * gelu_tanh(s0 * SU[e0] * sh) * SV[e0]); o.y = (_Float16)((float)gh.y * gelu_tanh(s1 * SU[e1] * sh) * SV[e1]);
        coef2[idx] = __builtin_bit_cast(unsigned, o); } }
  }
}

DEV void peer_ld_rows8(const __amdgpu_buffer_rsrc_t T, const int* le_lds, int half, int p8, int c, u32x4 (&R)[8]) {
#pragma unroll
  for (int j = 0; j < 8; ++j) R[j] = __builtin_amdgcn_raw_buffer_load_b128(T, le_lds[p8 * 16 + half * 8 + j] * 128 + c * 16, 0, 0);
}
DEV void peer_v_half(const u32x4 (&R)[8], const float* cf_lds, int half, int p8, f32x2 (&acc)[8]) {
#pragma unroll
  for (int j = 0; j < 8; ++j) { const float cj = cf_lds[p8 * 16 + half * 8 + j]; const f32x2 w = {cj, cj};
    acc[0] = __builtin_elementwise_fma(__builtin_amdgcn_cvt_pk_f32_fp8((int)R[j].x, false), w, acc[0]); acc[1] = __builtin_elementwise_fma(__builtin_amdgcn_cvt_pk_f32_fp8((int)R[j].x, true), w, acc[1]);
    acc[2] = __builtin_elementwise_fma(__builtin_amdgcn_cvt_pk_f32_fp8((int)R[j].y, false), w, acc[2]); acc[3] = __builtin_elementwise_fma(__builtin_amdgcn_cvt_pk_f32_fp8((int)R[j].y, true), w, acc[3]);
    acc[4] = __builtin_elementwise_fma(__builtin_amdgcn_cvt_pk_f32_fp8((int)R[j].z, false), w, acc[4]); acc[5] = __builtin_elementwise_fma(__builtin_amdgcn_cvt_pk_f32_fp8((int)R[j].z, true), w, acc[5]);
    acc[6] = __builtin_elementwise_fma(__builtin_amdgcn_cvt_pk_f32_fp8((int)R[j].w, false), w, acc[6]); acc[7] = __builtin_elementwise_fma(__builtin_amdgcn_cvt_pk_f32_fp8((int)R[j].w, true), w, acc[7]); }
}
DEV void peer_v_finish(f32x2 (&acc)[8], f32x2 x, f32x2 gg, float* out_n, int lane) {
  const int p8 = lane >> 3, c = lane & 7;
  float a[16];
#pragma unroll
  for (int q = 0; q < 8; ++q) { a[q] = acc[q].x; a[8 + q] = acc[q].y; acc[q] = (f32x2){0.f, 0.f}; }
  const bool b3 = (lane & 8) != 0, b4 = (lane & 16) != 0, b5 = (lane & 32) != 0;
  float t[8], u[4], v[2];
#pragma unroll
  for (int k = 0; k < 8; ++k) { const float snd = b3 ? a[2 * k] : a[2 * k + 1]; t[k] = (b3 ? a[2 * k + 1] : a[2 * k]) + dpp_mov<0x128>(snd, snd); }
#pragma unroll
  for (int k = 0; k < 4; ++k) u[k] = rs_swap16(t[2 * k], t[2 * k + 1]);
#pragma unroll
  for (int k = 0; k < 2; ++k) v[k] = rs_swap32(u[2 * k], u[2 * k + 1]);
  f32x2 o; o.x = x.x + gg.x * v[0]; o.y = x.y + gg.y * v[1];
  *(f32x2*)(out_n + 16 * c + 2 * p8) = o;
}
DEV void phase8v(const Params& p, const PeerMap& M, int tid, unsigned char* lds) {
  const int lane = tid & 63, w = __builtin_amdgcn_readfirstlane(tid >> 6), p8 = lane >> 3, c = lane & 7;
  const unsigned* LE = (const unsigned*)(p.ws + OFF_LE); const unsigned* CF = (const unsigned*)(p.ws + OFF_COEF);
  int* li = (int*)(lds + w * 4096); float* lc = (float*)(lds + w * 4096 + 2048);
  const int tp0 = ((2 * lane) & 7) * 16 + (lane >> 2);
  const int K = (M.tend - M.tbeg - w + 7) / 8;
  const int NS = 2 * K;
  const int c0 = 16 * c + 2 * p8;
  for (int s = M.vx; s < 8; s += M.nx) {
    const __amdgpu_buffer_rsrc_t T = __builtin_amdgcn_make_buffer_rsrc((void*)(p.ws + OFF_V + (size_t)s * 16384 * 128), 0, 16384 * 128, 0x00020000);
    const float* g2base = (const float*)(p.ws + OFF_MODS) + 5 * 1024 + s * 128;
    unsigned pe[2], pc[2];
    const __amdgpu_buffer_rsrc_t rs_le = __builtin_amdgcn_make_buffer_rsrc((void*)LE, 0, NTOK * 128 * 2, 0x00020000);
    const __amdgpu_buffer_rsrc_t rs_cf = __builtin_amdgcn_make_buffer_rsrc((void*)CF, 0, NTOK * 128 * 2, 0x00020000);
#define PV_FETCH_LISTS(chunk) do { _Pragma("unroll") for (int q = 0; q < 2; ++q) { const int kk = (chunk) * 2 + q; const int o = (kk < K ? M.tbeg + w + 8 * kk : M.tbeg) * 256; \
      pe[q] = __builtin_amdgcn_raw_buffer_load_b32(rs_le, lane * 4, o, 0); pc[q] = __builtin_amdgcn_raw_buffer_load_b32(rs_cf, lane * 4, o, 0); } } while (0)
#define PV_STORE_LISTS(buf) do { _Pragma("unroll") for (int q = 0; q < 2; ++q) { i32x2 e2_; e2_.x = (int)(pe[q] & 0xffffu); e2_.y = (int)(pe[q] >> 16); li[(buf) * 256 + q * 128 + tp0] = e2_.x; li[(buf) * 256 + q * 128 + tp0 + 16] = e2_.y; \
      const f16x2 c2_ = __builtin_bit_cast(f16x2, pc[q]); f32x2 cf2_; cf2_.x = (float)c2_.x; cf2_.y = (float)c2_.y; lc[(buf) * 256 + q * 128 + tp0] = cf2_.x; lc[(buf) * 256 + q * 128 + tp0 + 16] = cf2_.y; } } while (0)
    asm volatile("s_waitcnt lgkmcnt(0)" ::: "memory"); __builtin_amdgcn_wave_barrier();
    PV_FETCH_LISTS(0); PV_STORE_LISTS(0);
    PV_FETCH_LISTS(1);
    asm volatile("s_waitcnt lgkmcnt(0)" ::: "memory"); __builtin_amdgcn_wave_barrier();
    u32x4 R0[8], R1[8], R2[8], R3[8];
    f32x2 acc[8];
#pragma unroll
    for (int q = 0; q < 8; ++q) acc[q] = (f32x2){0.f, 0.f};
    peer_ld_rows8(T, li, 0, p8, c, R0); peer_ld_rows8(T, li, 1, p8, c, R1); peer_ld_rows8(T, li + 128, 0, p8, c, R2);
    f32x2 xo = {0.f, 0.f}, ggo = {0.f, 0.f};
#pragma unroll 1
    for (int ch = 0; ch * 4 < NS; ++ch) {
      const int cur = ch & 1, nxt = cur ^ 1;
      PV_STORE_LISTS(nxt);
      PV_FETCH_LISTS(ch + 2);
      asm volatile("s_waitcnt lgkmcnt(0)" ::: "memory"); __builtin_amdgcn_wave_barrier();
      const int* lic = li + cur * 256; const float* lcc = lc + cur * 256; const int* lin = li + nxt * 256;
      const int nb = M.tbeg + w + 8 * (ch * 2);
#define PV_STEP(st, RCUR, RNEXT) do { const int gs = ch * 4 + (st); \
          \
        if (gs < NS && ((st) & 1) == 0) { const int n_ = nb + 8 * ((st) >> 1); float* on = p.out + (size_t)n_ * 1024 + s * 128; const float* gn = g2base + mod_row(n_) * 6144; xo = *(const f32x2*)(on + c0); ggo = *(const f32x2*)(gn + c0); } \
        if (gs + 3 < NS) { __builtin_amdgcn_s_setprio(2); if ((st) + 3 < 4) peer_ld_rows8(T, lic + (((st) + 3) >> 1) * 128, ((st) + 3) & 1, p8, c, RNEXT); else peer_ld_rows8(T, lin + (((st) + 3 - 4) >> 1) * 128, ((st) + 3) & 1, p8, c, RNEXT); __builtin_amdgcn_s_setprio(0); } \
        if (gs < NS) { const int n = nb + 8 * ((st) >> 1); \
          peer_v_half(RCUR, lcc + ((st) >> 1) * 128, (st) & 1, p8, acc); \
          if (((st) & 1) == 1) peer_v_finish(acc, xo, ggo, p.out + (size_t)n * 1024 + s * 128, lane); } } while (0)
      PV_STEP(0, R0, R3); PV_STEP(1, R1, R0); PV_STEP(2, R2, R1); PV_STEP(3, R3, R2);
#undef PV_STEP
    }
#undef PV_FETCH_LISTS
#undef PV_STORE_LISTS
  }
}

#define XB_TMO      128
#define XB_XCNT(j)  (256  + 64 * (j))
#define XB_XSUB(j)  (1280 + 64 * (j))
#define XB_XGEN(j)  (2304 + 64 * (j))
#define XB_TOP      3328
#define XB_TOPGEN   3392
#define XB_SPIN_CAP (1u << 20)
#define LAS __attribute__((address_space(3)))
DEV unsigned xb_ld(unsigned* p) { return __hip_atomic_load(p, __ATOMIC_RELAXED, __HIP_MEMORY_SCOPE_AGENT); }
DEV unsigned xb_add(unsigned* p, unsigned v) { return __hip_atomic_fetch_add(p, v, __ATOMIC_RELAXED, __HIP_MEMORY_SCOPE_AGENT); }
DEV unsigned xb_xcc_id() { return (unsigned)__builtin_amdgcn_s_getreg((3 << 11) | 20) & 0xFu; }
#define XB_SPIN(cond, bar) do { unsigned _sp = 0; while (cond) { __builtin_amdgcn_s_sleep(1); \
    if ((++_sp & 255u) == 0u) { if (xb_ld(&(bar)[XB_TMO])) break; if (_sp > XB_SPIN_CAP) { atomicAdd(&(bar)[XB_TMO], 1u); break; } } } } while (0)
struct XcdBarrier { unsigned* bar; unsigned x; volatile LAS unsigned* st; };
#define XG_CNT(g, x) (4096 + (g) * 16 + (x))
#define XG_SUB(g, x) (4352 + ((g) * 16 + (x)) * 16)
#define XG_TOP(g)    (6400 + (g) * 32)
DEV XcdBarrier xcd_barrier_post(unsigned* bar, volatile LAS unsigned* st) {
  XcdBarrier b; b.bar = bar; b.x = xb_xcc_id(); b.st = st;
  if (threadIdx.x == 0) { (void)xb_add(&bar[XB_XCNT(b.x)], 1u); (void)xb_add(&bar[XG_CNT(blockIdx.x & 7, b.x)], 1u); }
  return b;
}
DEV void xcd_barrier_complete(unsigned* bar, unsigned x, unsigned& nloc, unsigned& nx) {
  const unsigned G = gridDim.x * gridDim.y * gridDim.z;
  unsigned sum, cnt, mine, sp = 0u;
  for (;;) {
    sum = 0u; cnt = 0u; mine = 0u;
#pragma unroll
    for (unsigned j = 0; j < 16; ++j) { const unsigned c = xb_ld(&bar[XB_XCNT(j)]); sum += c; cnt += (c > 0u) ? 1u : 0u; mine = (j == x) ? c : mine; }
    if (sum == G) break;
    __builtin_amdgcn_s_sleep(1);
    if ((++sp & 255u) == 0u) { if (xb_ld(&bar[XB_TMO])) break; if (sp > XB_SPIN_CAP) { atomicAdd(&bar[XB_TMO], 1u); break; } }
  }
  nloc = mine > 0u ? mine : 1u; nx = cnt > 0u ? cnt : 1u;
}
DEV void xcd_barrier(const XcdBarrier& b) {
  asm volatile("s_waitcnt vmcnt(0)" ::: "memory");
  __syncthreads();
  if (threadIdx.x == 0) {
    unsigned* bar = b.bar;
    __builtin_amdgcn_s_waitcnt(0);
    unsigned nloc = b.st[0], nx = b.st[1];
    if (nloc == 0u) { xcd_barrier_complete(bar, b.x, nloc, nx); b.st[0] = nloc; b.st[1] = nx; }
    const unsigned old = xb_add(&bar[XB_XSUB(b.x)], 1u);
    const unsigned gen = old / nloc;
    if (old + 1u == (gen + 1u) * nloc) {
      __builtin_amdgcn_fence(__ATOMIC_RELEASE, "agent");
      asm volatile("s_waitcnt vmcnt(0)" ::: "memory");
      (void)xb_add(&bar[XB_TOP], 1u);
    }
    const unsigned target = (gen + 1u) * nx;
    XB_SPIN(xb_ld(&bar[XB_TOP]) < target, bar);
    __builtin_amdgcn_fence(__ATOMIC_ACQUIRE, "agent");
    asm volatile("s_waitcnt vmcnt(0)" ::: "memory");
  }
  __syncthreads();
}

DEV void group_barrier(const XcdBarrier& b) {
  asm volatile("s_waitcnt vmcnt(0)" ::: "memory");
  __syncthreads();
  if (threadIdx.x == 0) {
    unsigned* bar = b.bar;
    __builtin_amdgcn_s_waitcnt(0);
    const unsigned g = blockIdx.x & 7u;
    unsigned nloc = b.st[2], ns = b.st[3];
    if (nloc == 0u) {
      const unsigned GS = (gridDim.x + 7u - g) / 8u;
      unsigned sum, cnt, mine, sp = 0u;
      for (;;) {
        sum = 0u; cnt = 0u; mine = 0u;
#pragma unroll
        for (unsigned j = 0; j < 16; ++j) { const unsigned c = xb_ld(&bar[XG_CNT(g, j)]); sum += c; cnt += (c > 0u) ? 1u : 0u; mine = (j == b.x) ? c : mine; }
        if (sum == GS) break;
        __builtin_amdgcn_s_sleep(1);
        if ((++sp & 255u) == 0u) { if (xb_ld(&bar[XB_TMO])) break; if (sp > XB_SPIN_CAP) { atomicAdd(&bar[XB_TMO], 1u); break; } }
      }
      nloc = mine > 0u ? mine : 1u; ns = cnt > 0u ? cnt : 1u; b.st[2] = nloc; b.st[3] = ns;
    }
    const unsigned old = xb_add(&bar[XG_SUB(g, b.x)], 1u);
    const unsigned gen = old / nloc;
    if (old + 1u == (gen + 1u) * nloc) {
      if (ns > 1u) __builtin_amdgcn_fence(__ATOMIC_RELEASE, "agent");
      asm volatile("s_waitcnt vmcnt(0)" ::: "memory");
      (void)xb_add(&bar[XG_TOP(g)], 1u);
    }
    const unsigned target = (gen + 1u) * ns;
    XB_SPIN(xb_ld(&bar[XG_TOP(g)]) < target, bar);
    __builtin_amdgcn_fence(__ATOMIC_ACQUIRE, "agent");
    asm volatile("s_waitcnt vmcnt(0)" ::: "memory");
  }
  __syncthreads();
}

#ifndef PROBE_PH
#define PROBE_PH -1
#endif
#define GROUP_SEAM(n) ((n) == 2 || (n) == 5 || (n) == 6 || (n) == 7)
#define RUN_PHASE(n, call) if (LO <= (n) && (n) <= HI) { if ((n) > LO) { if (GROUP_SEAM(n) && gridDim.x == 256) group_barrier(xb); else xcd_barrier(xb); } call; if ((n) == PROBE_PH) { xcd_barrier(xb); call; } }
template <int LO, int HI> __global__ void __launch_bounds__(512) mega(Params p) {
  __shared__ __attribute__((aligned(16))) unsigned char lds[147456 + 16];
  volatile LAS unsigned* xst = (volatile LAS unsigned*)(lds + 147456);
  if (threadIdx.x < 4) xst[threadIdx.x] = 0u;
  __syncthreads();
  XcdBarrier xb = xcd_barrier_post((unsigned*)(p.ws + OFF_BAR), xst);
  RUN_PHASE(0, phase0(p, lds))
  RUN_PHASE(1, phase_mod<0>(p, lds))
  RUN_PHASE(2, gemm256_inproj(p, lds))
  RUN_PHASE(3, phase3(p, lds))
  RUN_PHASE(4, gemm256_outproj(p, lds))
  RUN_PHASE(5, phase_mod<1>(p, lds))
  RUN_PHASE(6, gemm256_qp(p, lds))
  RUN_PHASE(7, phase7(p, lds))
  if (LO <= 8 && 8 <= HI) {
    if (8 > LO) xcd_barrier(xb);
    const int tid8 = tidx();
    const PeerMap M = peer_map(p, xb.x, xst[0], (unsigned*)lds);
    phase8ab<false>(p, M, tid8, lds);
    xcd_barrier(xb);
    phase8r(p);
    xcd_barrier(xb);
    phase8v(p, M, tid8, lds);
  }
}

extern "C" void kernel_launch(void* const* d_in, const int* in_sizes, int n_in, void* d_out, int out_size, void* d_ws, size_t ws_size, hipStream_t stream) {
  Params p{};
  p.x_prompt = (const float*)d_in[0]; p.x_sample = (const float*)d_in[1]; p.cache_k = (const float*)d_in[2]; p.cache_v = (const float*)d_in[3]; p.state = (const float*)d_in[4];
  p.c = (const float*)d_in[5]; p.c_ctx = (const float*)d_in[6]; p.w_ada = (const float*)d_in[7]; p.b_ada = (const float*)d_in[8]; p.norm1_g = (const float*)d_in[9]; p.norm2_g = (const float*)d_in[10];
  p.w_in = (const float*)d_in[11]; p.decay_f = (const float*)d_in[12]; p.decay_b = (const float*)d_in[13]; p.gn_g = (const float*)d_in[14]; p.qn_g = (const float*)d_in[15]; p.kn_g = (const float*)d_in[16];
  p.rpb = (const float*)d_in[17]; p.w_out = (const float*)d_in[18]; p.wq = (const float*)d_in[19]; p.keys = (const float*)d_in[20]; p.pu = (const float*)d_in[21]; p.pv = (const float*)d_in[22];
  p.out = (float*)d_out; p.ws = (unsigned char*)d_ws;
  static int grid_blocks = 0;
  if (!grid_blocks) {
    int dev = 0, cus = 0, per_cu = 0;
    (void)hipGetDevice(&dev);
    (void)hipDeviceGetAttribute(&cus, hipDeviceAttributeMultiprocessorCount, dev);
    (void)hipOccupancyMaxActiveBlocksPerMultiprocessor(&per_cu, (const void*)mega<0, 8>, 512, 0);
    if (per_cu > 1) per_cu = 1;
    grid_blocks = cus * per_cu;
  }
  (void)hipMemsetAsync(p.ws + OFF_BAR, 0, 32768, stream);
  void* args[] = {&p};
  hipError_t e = hipLaunchCooperativeKernel((const void*)mega<0, 8>, dim3(grid_blocks), dim3(512), args, 0, stream);
  if (e != hipSuccess) fprintf(stderr, "cooperative launch failed: %s (grid %d)\n", hipGetErrorString(e), grid_blocks);
}
```
